# Optimizing an MI355X kernel written in HIP

```python
import jax, jax.numpy as jnp
from jax import lax
import numpy as np

D_MODEL = 2048
BATCH = 4
SEQ = 2048
DEPTH = 1

D_MIX = D_MODEL
W_POOL = D_MIX // 2
W_LRU = D_MIX - W_POOL
POOL_WINDOWS = (2, 4, 8, 16)
N_POOL_GROUPS = len(POOL_WINDOWS)
POOL_GROUP = W_POOL // N_POOL_GROUPS
N_LRU_HEADS = 4
LRU_HEAD = W_LRU // N_LRU_HEADS
N_DIR = 2
CONV_WIDTH = 4
LRU_C = 8.0
EPS = 1e-6

kernel_name = "bidir_hybrid_pool_rglru_block"


def rms_norm(x, g):
    xf = x.astype(jnp.float32)
    y = xf * lax.rsqrt(jnp.mean(xf * xf, axis=-1, keepdims=True) + EPS)
    return (y * g.astype(jnp.float32)).astype(x.dtype)


def pool_mixer(u, w_pool, b_pool, pool_scale):
    B, S, _ = u.shape
    uf = u.astype(jnp.float32)
    cs = jnp.concatenate([jnp.zeros((B, 1, W_POOL), jnp.float32), jnp.cumsum(uf, axis=1)], axis=1)
    t = jnp.arange(S)
    outs = []
    for g, w in enumerate(POOL_WINDOWS):
        lo = w // 2
        hi = w - lo - 1
        start = jnp.maximum(t - lo, 0)
        end = jnp.minimum(t + hi, S - 1) + 1
        csg = cs[..., g * POOL_GROUP:(g + 1) * POOL_GROUP]
        total = csg[:, end, :] - csg[:, start, :]
        cnt = (end - start).astype(jnp.float32)[None, :, None]
        outs.append(total / cnt - uf[..., g * POOL_GROUP:(g + 1) * POOL_GROUP])
    pooled = jnp.stack(outs, axis=2).astype(u.dtype)
    mixed = jnp.einsum('bsgp,gpq->bsgq', pooled, w_pool) + b_pool
    return mixed.reshape(B, S, W_POOL) * pool_scale


def centred_dwconv(u, conv_w, conv_b):
    S = u.shape[1]
    left = CONV_WIDTH // 2
    up = jnp.pad(u, ((0, 0), (left, CONV_WIDTH - left - 1), (0, 0)))
    out = conv_b
    for k in range(CONV_WIDTH):
        out = out + up[:, k:k + S, :] * conv_w[k]
    return out


def linear_scan(a, b, reverse):
    def combine(l, r):
        a_l, b_l = l
        a_r, b_r = r
        return a_l * a_r, a_r * b_l + b_r
    _, h = lax.associative_scan(combine, (a, b), axis=1, reverse=reverse)
    return h


def bidir_rg_lru(u, w_gate, b_gate, lru_lambda):
    B, S, _ = u.shape
    uh = u.reshape(B, S, N_LRU_HEADS, LRU_HEAD)
    gates = jnp.einsum('bshc,nhce->nbshe', uh, w_gate) + b_gate[:, None, None]
    gates = jax.nn.sigmoid(gates.astype(jnp.float32))
    r = gates[..., :LRU_HEAD].reshape(N_DIR, B, S, W_LRU)
    i = gates[..., LRU_HEAD:].reshape(N_DIR, B, S, W_LRU)
    log_a = -LRU_C * r * jax.nn.softplus(-lru_lambda.astype(jnp.float32))[:, None, None, :]
    a = jnp.exp(log_a)
    mult = jnp.sqrt(-jnp.expm1(2.0 * log_a))
    bx = mult * i * u.astype(jnp.float32)[None]
    h_f = linear_scan(a[0], bx[0], reverse=False)
    h_b = linear_scan(a[1], bx[1], reverse=True)
    return (h_f + h_b).astype(u.dtype)


def setup_inputs(seed: int = 0) -> dict:
    key = jax.random.key(seed)
    ks = jax.random.split(key, 24)
    f32 = jnp.float32
    nrm = lambda k, shape, s: jax.random.normal(k, shape, f32) * s
    a0 = jax.random.uniform(ks[14], (DEPTH, N_DIR, W_LRU), f32, 0.9, 0.999)
    p = a0 ** (1.0 / LRU_C)
    lru_lambda = jnp.log(p) - jnp.log1p(-p)
    return {
        "x": nrm(ks[0], (BATCH, SEQ, D_MODEL), 1.0),
        "c": nrm(ks[1], (BATCH, D_MODEL), 1.0),
        "norm_g": 1.0 + nrm(ks[2], (DEPTH, D_MODEL), 0.02),
        "w_ada": nrm(ks[3], (DEPTH, D_MODEL, 3 * D_MODEL), 0.5 * D_MODEL ** -0.5),
        "b_ada": nrm(ks[4], (DEPTH, 3 * D_MODEL), 0.02),
        "w_in": nrm(ks[5], (DEPTH, D_MODEL, 2 * D_MIX), D_MODEL ** -0.5),
        "b_in": nrm(ks[6], (DEPTH, 2 * D_MIX), 0.02),
        "w_pool": nrm(ks[7], (DEPTH, N_POOL_GROUPS, POOL_GROUP, POOL_GROUP), POOL_GROUP ** -0.5),
        "b_pool": nrm(ks[8], (DEPTH, N_POOL_GROUPS, POOL_GROUP), 0.02),
        "pool_scale": 1.0 + nrm(ks[9], (DEPTH, W_POOL), 0.1),
        "conv_w": nrm(ks[10], (DEPTH, CONV_WIDTH, W_LRU), CONV_WIDTH ** -0.5),
        "conv_b": nrm(ks[11], (DEPTH, W_LRU), 0.02),
        "w_gate": nrm(ks[12], (DEPTH, N_DIR, N_LRU_HEADS, LRU_HEAD, 2 * LRU_HEAD), LRU_HEAD ** -0.5),
        "b_gate": nrm(ks[13], (DEPTH, N_DIR, N_LRU_HEADS, 2 * LRU_HEAD), 0.02),
        "lru_lambda": lru_lambda,
        "out_norm_pool_g": 1.0 + nrm(ks[15], (DEPTH, W_POOL), 0.02),
        "out_norm_lru_g": 1.0 + nrm(ks[16], (DEPTH, W_LRU), 0.02),
        "w_out": nrm(ks[17], (DEPTH, D_MIX, D_MODEL), D_MIX ** -0.5),
        "b_out": nrm(ks[18], (DEPTH, D_MODEL), 0.02),
        "final_norm_g": 1.0 + nrm(ks[19], (D_MODEL,), 0.02),
    }


def reference(x, c, norm_g, w_ada, b_ada, w_in, b_in, w_pool, b_pool, pool_scale,
              conv_w, conv_b, w_gate, b_gate, lru_lambda, out_norm_pool_g, out_norm_lru_g,
              w_out, b_out, final_norm_g):
    c_act = jax.nn.silu(c)
    for l in range(DEPTH):
        mod = c_act @ w_ada[l] + b_ada[l]
        shift, scale, gate = jnp.split(mod, 3, axis=-1)
        h = rms_norm(x, norm_g[l]) * (1.0 + scale[:, None, :]) + shift[:, None, :]
        z = h @ w_in[l] + b_in[l]
        u_pool = z[..., :W_POOL]
        u_lru = z[..., W_POOL:D_MIX]
        g_pool = z[..., D_MIX:D_MIX + W_POOL]
        g_lru = z[..., D_MIX + W_POOL:]
        y_pool = pool_mixer(u_pool, w_pool[l], b_pool[l], pool_scale[l])
        y_lru = bidir_rg_lru(centred_dwconv(u_lru, conv_w[l], conv_b[l]),
                             w_gate[l], b_gate[l], lru_lambda[l])
        y_pool = rms_norm(y_pool, out_norm_pool_g[l]) * jax.nn.silu(g_pool)
        y_lru = rms_norm(y_lru, out_norm_lru_g[l]) * jax.nn.silu(g_lru)
        y = jnp.concatenate([y_pool, y_lru], axis=-1) @ w_out[l] + b_out[l]
        x = x + gate[:, None, :] * y
    return rms_norm(x, final_norm_g)
```

```cpp
#include <hip/hip_runtime.h>
#include <hip/hip_cooperative_groups.h>
#include <cstdio>
#include <cstdint>
namespace cg = cooperative_groups;

#ifndef MK_N_LAUNCHES
#define MK_N_LAUNCHES 1
#endif
#ifndef PROBE_MASK
#define PROBE_MASK 256
#endif

namespace pg8 {
#define PG8_LAS __attribute__((address_space(3)))
typedef unsigned short bf16_t;
typedef short bf16x8 __attribute__((ext_vector_type(8)));
typedef float f32x4 __attribute__((ext_vector_type(4)));
typedef unsigned u32x4 __attribute__((ext_vector_type(4)));
typedef unsigned u32x2 __attribute__((ext_vector_type(2)));
constexpr int BM = 256, BK = 64, HALF = 128, HTB = HALF * BK * 2, STAGE_BYTES = 8 * HTB, NXCD = 8, WGM = 8;

__host__ __device__ __forceinline__ int lds_byte(int r, int c) { const int st = (r >> 4) * 2 + (c >> 5), rr = r & 15, cc = c & 31, ob = rr * 64 + cc * 2; return st * 1024 + (ob ^ (((ob >> 9) & 1) << 5)); }
__host__ __device__ __forceinline__ void stage_rc(int b, int& R, int& C) { const int st = b / 1024, sb = b % 1024, swz = sb ^ (((sb >> 9) & 1) << 5); R = (st >> 1) * 16 + swz / 64; C = (st & 1) * 32 + (swz % 64) / 2; }
__host__ __device__ __forceinline__ int perm32(int rho) { const int n = rho >> 4, i = rho & 15; return 8 * (i >> 2) + 4 * n + (i & 3); }

struct Unit { int pm, pn; };
struct Gemm { const bf16_t* A; const bf16_t* Bt; int M, N, K, lda, ashift, amask; };

struct StaticOrder {
    int nM, nN, nwg, G, c;
    __host__ __device__ void init(int M, int N, int G_, int c_) { nM = M / BM; nN = N / BM; nwg = nM * nN; G = G_; c = c_; }
    __host__ __device__ bool next(int i, Unit& u) const {
        const long L = (long)i * G + c; if (L >= nwg) return false;
        int wgid = (int)L; { const int q = nwg / NXCD, r = nwg % NXCD, xcd = wgid % NXCD, off = wgid / NXCD; wgid = (xcd < r ? xcd * (q + 1) : r * (q + 1) + (xcd - r) * q) + off; }
        const int nig = WGM * nN, gid = wgid / nig, fm = gid * WGM, gsz = (nM - fm) < WGM ? (nM - fm) : WGM;
        u.pm = fm + ((wgid % nig) % gsz); u.pn = (wgid % nig) / gsz; return true;
    }
    __device__ __forceinline__ void a_ready(const Unit&) const {}
    __device__ __forceinline__ void done(const Unit&) const {}
};

__device__ __forceinline__ unsigned cvt_pk_bf16(float lo, float hi) { unsigned r; asm volatile("v_cvt_pk_bf16_f32 %0, %1, %2" : "=v"(r) : "v"(lo), "v"(hi)); return r; }

struct EpiBf16 {
    static constexpr bool PERM = true, AFTER_DRAIN = false;
    bf16_t* O; int ldc; const float* bias; const float* scale;
    __device__ __forceinline__ void operator()(const f32x4 (&acc)[2][2][4][2], const Unit& u, int wr, int wc, int fr, int fq) const {
        const int row0 = u.pm * BM + wr * 64 + fr; const int col0 = u.pn * BM + wc * 32 + 8 * fq;
        f32x4 bv[2][2], sv[2][2];
#pragma unroll
        for (int bj = 0; bj < 2; ++bj)
#pragma unroll
            for (int n = 0; n < 2; ++n) { bv[bj][n] = *(const f32x4*)(bias + col0 + bj * HALF + 4 * n); sv[bj][n] = scale ? *(const f32x4*)(scale + col0 + bj * HALF + 4 * n) : (f32x4){1.f, 1.f, 1.f, 1.f}; }
#pragma unroll
        for (int ai = 0; ai < 2; ++ai)
#pragma unroll
            for (int m = 0; m < 4; ++m) { bf16_t* rowp = O + (size_t)(row0 + ai * HALF + m * 16) * ldc + col0;
#pragma unroll
                for (int bj = 0; bj < 2; ++bj) { f32x4 v0 = (acc[ai][bj][m][0] + bv[bj][0]) * sv[bj][0], v1 = (acc[ai][bj][m][1] + bv[bj][1]) * sv[bj][1];
                    u32x4 w; w.x = cvt_pk_bf16(v0[0], v0[1]); w.y = cvt_pk_bf16(v0[2], v0[3]); w.z = cvt_pk_bf16(v1[0], v1[1]); w.w = cvt_pk_bf16(v1[2], v1[3]);
                    *(u32x4*)(rowp + bj * HALF) = w; } }
    }
};
struct EpiResid {
    static constexpr bool PERM = false, AFTER_DRAIN = false;
    float* out; const float* x; const float* gate; const float* bias; int ldc; int rows_per_batch;
    __device__ __forceinline__ void operator()(const f32x4 (&acc)[2][2][4][2], const Unit& u, int wr, int wc, int fr, int fq) const {
        const int row0 = u.pm * BM + wr * 64 + fr, col0 = u.pn * BM + wc * 32 + 4 * fq;
        const float* gp = gate + (size_t)((u.pm * BM) / rows_per_batch) * ldc;
        f32x4 bv[2][2], gv[2][2];
#pragma unroll
        for (int bj = 0; bj < 2; ++bj)
#pragma unroll
            for (int n = 0; n < 2; ++n) { bv[bj][n] = *(const f32x4*)(bias + col0 + bj * HALF + n * 16); gv[bj][n] = *(const f32x4*)(gp + col0 + bj * HALF + n * 16); }
#pragma unroll
        for (int ai = 0; ai < 2; ++ai)
#pragma unroll
            for (int m = 0; m < 4; ++m) { const size_t ro = (size_t)(row0 + ai * HALF + m * 16) * ldc + col0;
#pragma unroll
                for (int bj = 0; bj < 2; ++bj)
#pragma unroll
                    for (int n = 0; n < 2; ++n) { const f32x4 xv = *(const f32x4*)(x + ro + bj * HALF + n * 16);
                        *(f32x4*)(out + ro + bj * HALF + n * 16) = xv + gv[bj][n] * (acc[ai][bj][m][n] + bv[bj][n]); } }
    }
};

struct EpiResidNorm {
    static constexpr bool PERM = false, AFTER_DRAIN = true;
    float* out; const float* x; const float* gate; const float* bias; const float* fg; int ldc; int rows_per_batch;
    float* slots;
    unsigned* cnt;
    int nN; float eps;
    __device__ __forceinline__ void operator()(const f32x4 (&)[2][2][4][2], const Unit&, int, int, int, int) const {}
    __device__ __forceinline__ void fused(f32x4 (&acc)[2][2][4][2], const Unit& u, int wr, int wc, int fr, int fq, PG8_LAS unsigned char* lds, int wid, int lane) const {
        constexpr int LPT = 260;
        const int tid = threadIdx.x;
        PG8_LAS float* T = (PG8_LAS float*)lds;
        const int colg = u.pn * BM + 4 * lane;
        const float* gp = gate + (size_t)((u.pm * BM) / rows_per_batch) * ldc;
        const f32x4 bvec = *(const f32x4*)(bias + colg), gvec = *(const f32x4*)(gp + colg);
        f32x4 v[2][16]; float mine = 0.f;
#pragma unroll
        for (int ai = 0; ai < 2; ++ai) {
            const size_t row0 = (size_t)(u.pm * BM + ai * HALF + wid * 16);
            f32x4 xr[16];
#pragma unroll
            for (int i = 0; i < 16; ++i) xr[i] = __builtin_nontemporal_load((const f32x4*)(x + (row0 + i) * ldc + colg));
#pragma unroll
            for (int m = 0; m < 4; ++m)
#pragma unroll
                for (int bj = 0; bj < 2; ++bj)
#pragma unroll
                    for (int n = 0; n < 2; ++n) *(PG8_LAS f32x4*)(T + (64 * wr + 16 * m + fr) * LPT + 128 * bj + 32 * wc + 16 * n + 4 * fq) = acc[ai][bj][m][n];
            __syncthreads();
#pragma unroll
            for (int i = 0; i < 16; ++i) { const f32x4 a = *(const PG8_LAS f32x4*)(T + (wid * 16 + i) * LPT + 4 * lane);
                const f32x4 vv = xr[i] + gvec * (a + bvec); v[ai][i] = vv;
                float sq = (vv.x * vv.x + vv.y * vv.y) + (vv.z * vv.z + vv.w * vv.w);
#pragma unroll
                for (int o = 1; o < 64; o <<= 1) sq += __shfl_xor(sq, o);
                mine = (lane == ai * 16 + i) ? sq : mine; }
            __syncthreads();
        }
        if (lane < 32) __hip_atomic_store(slots + (size_t)u.pn * M_total() + u.pm * BM + (lane >> 4) * HALF + wid * 16 + (lane & 15), mine, __ATOMIC_RELAXED, __HIP_MEMORY_SCOPE_AGENT);
        asm volatile("s_waitcnt vmcnt(0)" ::: "memory");
        __syncthreads();
        if (tid == 0) {
            __builtin_amdgcn_fence(__ATOMIC_RELEASE, "agent");
            asm volatile("s_waitcnt vmcnt(0)" ::: "memory");
            unsigned* c = cnt + 64 * u.pm;
            (void)__hip_atomic_fetch_add(c, 1u, __ATOMIC_RELAXED, __HIP_MEMORY_SCOPE_AGENT);
            unsigned sp = 0;
            while (__hip_atomic_load(c, __ATOMIC_RELAXED, __HIP_MEMORY_SCOPE_AGENT) < (unsigned)nN) { __builtin_amdgcn_s_sleep(1); if (++sp > (1u << 22)) break; }
            __builtin_amdgcn_fence(__ATOMIC_ACQUIRE, "agent");
            asm volatile("s_waitcnt vmcnt(0)" ::: "memory");
        }
        __syncthreads();
        float rl; { float sacc = 0.f; const size_t so = (size_t)u.pm * BM + ((lane >> 4) & 1) * HALF + wid * 16 + (lane & 15);
            for (int p = 0; p < nN; ++p) sacc += __hip_atomic_load(slots + (size_t)p * M_total() + so, __ATOMIC_RELAXED, __HIP_MEMORY_SCOPE_AGENT);
            rl = rsqrtf(sacc * (1.f / (float)ldc) + eps); }
        const f32x4 fvec = *(const f32x4*)(fg + colg);
#pragma unroll
        for (int ai = 0; ai < 2; ++ai) {
            const size_t row0 = (size_t)(u.pm * BM + ai * HALF + wid * 16);
#pragma unroll
            for (int i = 0; i < 16; ++i) { const float rstd = __shfl(rl, ai * 16 + i);
                __builtin_nontemporal_store(v[ai][i] * rstd * fvec, (f32x4*)(out + (row0 + i) * ldc + colg)); }
        }
    }
    int Mtot;
    __device__ __forceinline__ size_t M_total() const { return (size_t)Mtot; }
};

__device__ __forceinline__ float fexp(float x) { return __builtin_amdgcn_exp2f(x * 1.44269504f); }
__device__ __forceinline__ float fsigmoid(float x) { return __builtin_amdgcn_rcpf(1.f + __builtin_amdgcn_exp2f(x * -1.44269504f)); }
struct SingleUnit { Unit u0;
    __device__ __forceinline__ bool next(int i, Unit& u) const { if (i != 0) return false; u = u0; return true; }
    __device__ __forceinline__ void a_ready(const Unit&) const {}
    __device__ __forceinline__ void done(const Unit&) const {}
};
__host__ __device__ __forceinline__ int gate_row_map(int e) { const int n = e >> 8, c = e & 255, hf = c >> 7, cl = c & 127; return hf * 256 + (cl >> 4) * 32 + n * 16 + (cl & 15); }
struct EpiGateScan {
    static constexpr bool PERM = false, AFTER_DRAIN = true;
    static constexpr int LP = 132;
    const bf16_t* UC; const float* bgate; const float* lam; bf16_t* HLF; bf16_t* HLB; bf16_t* PF; bf16_t* PB; float* AGG; int seq, nchunk;
    __device__ __forceinline__ void operator()(const f32x4 (&)[2][2][4][2], const Unit&, int, int, int, int) const {}
    __device__ __forceinline__ void fused(f32x4 (&acc)[2][2][4][2], const Unit& u, int wr_, int wc_, int fr_, int fq_, PG8_LAS unsigned char* lds, int wid_, int lane_) const {
        int zero; asm volatile("v_mov_b32 %0, 0" : "=v"(zero));
        const int tid = (int)threadIdx.x + zero, lane = tid & 63, wid = __builtin_amdgcn_readfirstlane(tid >> 6), wr = wid >> 2, wc = wid & 3, fr = lane & 15, fq = lane >> 4;
        const int mi = u.pn >> 1, hf = u.pn & 1, dir = mi >> 2, head = mi & 3, chbase = head * 256 + hf * 128;
        bf16_t* HL = dir ? HLB : HLF; bf16_t* PP = dir ? PB : PF;
        PG8_LAS float* Aarr = (PG8_LAS float*)lds; PG8_LAS float* Barr = Aarr + 128 * LP; PG8_LAS float* SA = Barr + 128 * LP; PG8_LAS float* SH = SA + 512;
#pragma unroll
        for (int ai = 0; ai < 2; ++ai) {
            const int grow0 = u.pm * BM + HALF * ai;
        f32x4 br[2], bi[2], sp8[2];
#pragma unroll
            for (int bj = 0; bj < 2; ++bj) { const int cl0 = 64 * bj + 16 * wc + 4 * fq;
                br[bj] = *(const f32x4*)(bgate + mi * 512 + hf * 128 + cl0) * -1.44269504f; bi[bj] = *(const f32x4*)(bgate + mi * 512 + 256 + hf * 128 + cl0) * -1.44269504f;
                sp8[bj] = *(const f32x4*)(lam + dir * 1024 + chbase + cl0); }

#pragma unroll
            for (int m = 0; m < 4; ++m) { const int rl = 64 * wr + 16 * m + fr;
#pragma unroll
                for (int bj = 0; bj < 2; ++bj) { const int cl0 = 64 * bj + 16 * wc + 4 * fq;
                    const u32x2 uw = *(const u32x2*)(UC + (size_t)(grow0 + rl) * 1024 + chbase + cl0);
                    const float uu[4] = {__builtin_bit_cast(float, uw.x << 16), __builtin_bit_cast(float, uw.x & 0xffff0000u), __builtin_bit_cast(float, uw.y << 16), __builtin_bit_cast(float, uw.y & 0xffff0000u)};
                    const f32x4 gr = acc[ai][bj][m][0] + br[bj], gi = acc[ai][bj][m][1] + bi[bj];
                    f32x4 av, bxv;
#pragma unroll
                    for (int e = 0; e < 4; ++e) {
                        const float dr = 1.f + __builtin_amdgcn_exp2f(fminf(gr[e], 60.f)), di = 1.f + __builtin_amdgcn_exp2f(fminf(gi[e], 60.f));
                        const float inv = __builtin_amdgcn_rcpf(dr * di), r = inv * di, ig = inv * dr;
                        const float a = __builtin_amdgcn_exp2f(r * sp8[bj][e]);
                        const float m2 = __builtin_fmaf(-a, a, 1.f);
                        av[e] = a; bxv[e] = __builtin_amdgcn_sqrtf(m2) * ig * uu[e]; }
                    *(PG8_LAS f32x4*)(Aarr + rl * LP + cl0) = av; *(PG8_LAS f32x4*)(Barr + rl * LP + cl0) = bxv; }
                asm volatile("" ::: "memory"); }
            __syncthreads();
            { const int cl = tid & 127, sg = tid >> 7; float h = 0.f, P = 1.f;
              PG8_LAS float* pa = Aarr + (dir ? 127 - 32 * sg : 32 * sg) * LP + cl; PG8_LAS float* pb = Barr + (dir ? 127 - 32 * sg : 32 * sg) * LP + cl; const int st = dir ? -LP : LP;
              float va[32], vb[32];
#pragma unroll
              for (int k = 0; k < 32; ++k) { va[k] = pa[k * st]; vb[k] = pb[k * st]; }
#pragma unroll
              for (int k = 0; k < 32; ++k) { h = va[k] * h + vb[k]; P *= va[k]; va[k] = P; vb[k] = h; }
              SA[sg * 128 + cl] = P; SH[sg * 128 + cl] = h;
              __syncthreads();
              float cin = 0.f, pp = 1.f;
#pragma unroll
              for (int s2 = 0; s2 < 3; ++s2) { const float Ps = SA[s2 * 128 + cl], Hs = SH[s2 * 128 + cl]; if (s2 < sg) { cin = Hs + Ps * cin; pp *= Ps; } }
#pragma unroll
              for (int k = 0; k < 32; ++k) { pb[k * st] = vb[k] + va[k] * cin; pa[k * st] = va[k] * pp; } }
            __syncthreads();
#pragma unroll 1
            for (int k = 0; k < 4; ++k) { const int item = tid + 512 * k, o = item & 15, rl = item >> 4, p = dir ? 127 - rl : rl;
                const f32x4 a0 = *(const PG8_LAS f32x4*)(Aarr + rl * LP + 8 * o), a1 = *(const PG8_LAS f32x4*)(Aarr + rl * LP + 8 * o + 4);
                const f32x4 h0 = *(const PG8_LAS f32x4*)(Barr + rl * LP + 8 * o), h1 = *(const PG8_LAS f32x4*)(Barr + rl * LP + 8 * o + 4);
                const size_t go = (size_t)(grow0 + rl) * 1024 + chbase + 8 * o;
                u32x4 wh, wp; wh.x = cvt_pk_bf16(h0[0], h0[1]); wh.y = cvt_pk_bf16(h0[2], h0[3]); wh.z = cvt_pk_bf16(h1[0], h1[1]); wh.w = cvt_pk_bf16(h1[2], h1[3]);
                wp.x = cvt_pk_bf16(a0[0], a0[1]); wp.y = cvt_pk_bf16(a0[2], a0[3]); wp.z = cvt_pk_bf16(a1[0], a1[1]); wp.w = cvt_pk_bf16(a1[2], a1[3]);
                *(u32x4*)(HL + go) = wh; *(u32x4*)(PP + go) = wp;
                if (p == 127) { const int b = grow0 / seq, chunk = (grow0 % seq) / HALF;
                    float* ag = AGG + (size_t)(((b * nchunk + chunk) * 2 + dir) * 2) * 1024 + chbase + 8 * o;
                    *(f32x4*)(ag) = a0; *(f32x4*)(ag + 4) = a1; *(f32x4*)(ag + 1024) = h0; *(f32x4*)(ag + 1028) = h1; }
            }
            __syncthreads();
        }
    }
};

template <class Epi, class Sched, bool ALIGN_EPI = false, bool SP2 = false>
__device__ __forceinline__ void gemm_phase(PG8_LAS unsigned char* lds, const Gemm g, const Sched& S, const Epi& E) {
    int zero_; asm volatile("v_mov_b32 %0, 0" : "=v"(zero_));
    const int tid = (int)threadIdx.x + zero_, wid = __builtin_amdgcn_readfirstlane(tid >> 6), lane = tid & 63, wr = wid >> 2, wc = wid & 3, fr = lane & 15, fq = lane >> 4;
    const int K = g.K, nt = K / BK, lda = g.lda;
    unsigned voffA[2], voffB[2];
#pragma unroll
    for (int i = 0; i < 2; ++i) { int R, C; stage_rc(tid * 16 + i * 8192, R, C); const int Rb = Epi::PERM ? ((R & ~31) + perm32(R & 31)) : R;
        voffA[i] = (unsigned)(R * lda + C) * 2u; voffB[i] = (unsigned)(Rb * K + C) * 2u; }
    const size_t kstep = (size_t)(BK * 2);
    const size_t hsA = (size_t)HALF * lda * 2, hsB = (size_t)HALF * K * 2;
    const size_t tsA = 2 * hsA, tsB = 2 * hsB;
    const unsigned ldsw = (unsigned)wid * 1024u;
    const int aoff = lds_byte(wr * 64 + fr, fq * 8), boff = lds_byte(wc * 32 + fr, fq * 8);
#define PG8_SA(b, h) (((b) * 2 + (h)) * HTB)
#define PG8_SB(b, h) ((4 + (b) * 2 + (h)) * HTB)
#define PG8_STAGE(bufoff, gbase, voff) do { _Pragma("unroll") for (int _i = 0; _i < 2; ++_i) \
        __builtin_amdgcn_global_load_lds((const unsigned*)((const char*)(gbase) + (voff)[_i]), (PG8_LAS unsigned*)(lds + (bufoff) + ldsw + _i * 8192), 16, 0, 0); } while (0)
#define PG8_LDA(dst, b, h) do { _Pragma("unroll") for (int m = 0; m < 4; ++m) _Pragma("unroll") for (int k = 0; k < 2; ++k) dst[m][k] = *(const PG8_LAS bf16x8*)(lds + PG8_SA(b, h) + aoff + m * 2048 + k * 1024); } while (0)
#define PG8_LDB(dst, b, h) do { _Pragma("unroll") for (int n = 0; n < 2; ++n) _Pragma("unroll") for (int k = 0; k < 2; ++k) dst[n][k] = *(const PG8_LAS bf16x8*)(lds + PG8_SB(b, h) + boff + n * 2048 + k * 1024); } while (0)
#define PG8_MMA(ai, bj, At, Bt) do { __builtin_amdgcn_s_setprio(1); _Pragma("unroll") for (int m = 0; m < 4; ++m) _Pragma("unroll") for (int n = 0; n < 2; ++n) _Pragma("unroll") for (int k = 0; k < 2; ++k) \
        acc[ai][bj][m][n] = __builtin_amdgcn_mfma_f32_16x16x32_bf16(Bt[n][k], At[m][k], acc[ai][bj][m][n], 0, 0, 0); __builtin_amdgcn_s_setprio(0); } while (0)
#define PG8_WAIT_V(n) asm volatile("s_waitcnt vmcnt(" #n ")" ::: "memory")
#define PG8_WAIT_L(n) asm volatile("s_waitcnt lgkmcnt(" #n ")" ::: "memory")
#define PG8_BAR __builtin_amdgcn_s_barrier()
#define PG8_SCHED __builtin_amdgcn_sched_barrier(0)
#define PG8_APTR(u) ((const char*)g.A + (size_t)(u).pm * tsA + (size_t)((((u).pn >> g.ashift) & g.amask) * K) * 2)
    Unit cur, nxt; int ui = 0;
    if (!S.next(0, cur)) return;
    f32x4 acc[2][2][4][2];
#pragma unroll
    for (int a = 0; a < 2; ++a)
#pragma unroll
        for (int b = 0; b < 2; ++b)
#pragma unroll
            for (int m = 0; m < 4; ++m)
#pragma unroll
                for (int n = 0; n < 2; ++n) acc[a][b][m][n] = (f32x4){0.f, 0.f, 0.f, 0.f};
    bf16x8 At[4][2], B0[2][2], B1[2][2];
    const char* cA = PG8_APTR(cur); const char* cB = (const char*)g.Bt + (size_t)cur.pn * tsB;
    S.a_ready(cur);
    if constexpr (SP2) {
        PG8_STAGE(PG8_SB(0, 0), cB, voffB); PG8_STAGE(PG8_SB(0, 1), cB + hsB, voffB); PG8_STAGE(PG8_SA(0, 0), cA, voffA); PG8_STAGE(PG8_SA(0, 1), cA + hsA, voffA);
        if (wr == 1) PG8_BAR;
        PG8_WAIT_V(2); PG8_BAR;
        PG8_STAGE(PG8_SB(1, 0), cB + kstep, voffB); PG8_STAGE(PG8_SA(1, 0), cA + kstep, voffA); PG8_STAGE(PG8_SB(1, 1), cB + hsB + kstep, voffB);
        PG8_WAIT_V(6); PG8_BAR;
    } else {
        PG8_STAGE(PG8_SB(0, 0), cB, voffB); PG8_STAGE(PG8_SA(0, 0), cA, voffA); PG8_STAGE(PG8_SB(0, 1), cB + hsB, voffB); PG8_STAGE(PG8_SA(0, 1), cA + hsA, voffA);
        if (wr == 1) PG8_BAR;
        PG8_WAIT_V(4); PG8_BAR;
        PG8_STAGE(PG8_SB(1, 0), cB + kstep, voffB); PG8_STAGE(PG8_SA(1, 0), cA + kstep, voffA); PG8_STAGE(PG8_SB(1, 1), cB + hsB + kstep, voffB);
        PG8_WAIT_V(6); PG8_BAR;
    }
    for (;;) {
        const bool has_next = S.next(ui + 1, nxt);
        const char* nA = has_next ? PG8_APTR(nxt) : cA; const char* nB = has_next ? (const char*)g.Bt + (size_t)nxt.pn * tsB : cB;
        for (int t = 0; t < nt; t += 2) {
            const bool last = (t == nt - 2);
            const char* a1 = cA + (size_t)(t + 1) * kstep;
            const char* a2 = last ? nA : cA + (size_t)(t + 2) * kstep; const char* b2 = last ? nB : cB + (size_t)(t + 2) * kstep;
            const char* a3 = a2 + kstep; const char* b3 = b2 + kstep;
            if (last && has_next) S.a_ready(nxt);
            if constexpr (SP2) {
            PG8_LDB(B0, 0, 0); PG8_LDB(B1, 0, 1); PG8_SCHED; PG8_LDA(At, 0, 0); PG8_STAGE(PG8_SA(1, 1), a1 + hsA, voffA);
            PG8_WAIT_V(8); PG8_WAIT_L(0); PG8_BAR; PG8_MMA(0, 0, At, B0); PG8_MMA(0, 1, At, B1); PG8_BAR; PG8_SCHED;
            PG8_LDA(At, 0, 1); PG8_STAGE(PG8_SB(0, 0), b2, voffB); PG8_STAGE(PG8_SB(0, 1), b2 + hsB, voffB); PG8_STAGE(PG8_SA(0, 0), a2, voffA);
            PG8_WAIT_V(8); PG8_WAIT_L(0); PG8_BAR; PG8_MMA(1, 0, At, B0); PG8_MMA(1, 1, At, B1); PG8_BAR; PG8_SCHED;
            PG8_LDB(B0, 1, 0); PG8_LDB(B1, 1, 1); PG8_SCHED; PG8_LDA(At, 1, 0); PG8_STAGE(PG8_SA(0, 1), a2 + hsA, voffA);
            PG8_WAIT_V(8); PG8_WAIT_L(0); PG8_BAR; PG8_MMA(0, 0, At, B0); PG8_MMA(0, 1, At, B1); PG8_BAR; PG8_SCHED;
            PG8_LDA(At, 1, 1); PG8_STAGE(PG8_SB(1, 0), b3, voffB); PG8_STAGE(PG8_SB(1, 1), b3 + hsB, voffB); PG8_STAGE(PG8_SA(1, 0), a3, voffA);
            PG8_WAIT_V(8); PG8_WAIT_L(0); PG8_BAR; PG8_MMA(1, 0, At, B0); PG8_MMA(1, 1, At, B1); PG8_BAR; PG8_SCHED;
            } else {
            PG8_LDB(B0, 0, 0); PG8_SCHED; PG8_LDA(At, 0, 0); PG8_STAGE(PG8_SA(1, 1), a1 + hsA, voffA);
            PG8_WAIT_L(8); PG8_BAR; PG8_WAIT_L(0); PG8_MMA(0, 0, At, B0); PG8_BAR; PG8_SCHED;
            PG8_LDB(B1, 0, 1); PG8_STAGE(PG8_SB(0, 0), b2, voffB);
            PG8_BAR; PG8_WAIT_L(0); PG8_MMA(0, 1, At, B1); PG8_BAR;
            PG8_LDA(At, 0, 1); PG8_STAGE(PG8_SA(0, 0), a2, voffA);
            PG8_BAR; PG8_WAIT_L(0); PG8_MMA(1, 0, At, B0); PG8_BAR; PG8_SCHED;
            PG8_STAGE(PG8_SB(0, 1), b2 + hsB, voffB);
            PG8_WAIT_V(6); PG8_BAR; PG8_MMA(1, 1, At, B1); PG8_BAR;
            PG8_LDB(B0, 1, 0); PG8_SCHED; PG8_LDA(At, 1, 0); PG8_STAGE(PG8_SA(0, 1), a2 + hsA, voffA);
            PG8_WAIT_L(8); PG8_BAR; PG8_WAIT_L(0); PG8_MMA(0, 0, At, B0); PG8_BAR; PG8_SCHED;
            PG8_LDB(B1, 1, 1); PG8_STAGE(PG8_SB(1, 0), b3, voffB);
            PG8_BAR; PG8_WAIT_L(0); PG8_MMA(0, 1, At, B1); PG8_BAR;
            PG8_LDA(At, 1, 1); PG8_STAGE(PG8_SA(1, 0), a3, voffA);
            PG8_BAR; PG8_WAIT_L(0); PG8_MMA(1, 0, At, B0); PG8_BAR; PG8_SCHED;
            PG8_STAGE(PG8_SB(1, 1), b3 + hsB, voffB);
            PG8_WAIT_V(6); PG8_BAR; PG8_MMA(1, 1, At, B1); PG8_BAR;
            }
        }
        if constexpr (ALIGN_EPI) { if (wr == 0) PG8_BAR; }
        if constexpr (!Epi::AFTER_DRAIN) { E(acc, cur, wr, wc, fr, fq); S.done(cur); }
        if (!has_next) break;
#pragma unroll
        for (int a = 0; a < 2; ++a)
#pragma unroll
            for (int b = 0; b < 2; ++b)
#pragma unroll
                for (int m = 0; m < 4; ++m)
#pragma unroll
                    for (int n = 0; n < 2; ++n) acc[a][b][m][n] = (f32x4){0.f, 0.f, 0.f, 0.f};
        cur = nxt; cA = nA; cB = nB; ++ui;
        if constexpr (ALIGN_EPI) { if (wr == 1) PG8_BAR; }
    }
    PG8_WAIT_V(0);
    if constexpr (!ALIGN_EPI) { if (wr == 0) PG8_BAR; }
    PG8_BAR;
    if constexpr (Epi::AFTER_DRAIN) { E.fused(acc, cur, wr, wc, fr, fq, lds, wid, lane); S.done(cur); }
#undef PG8_APTR
#undef PG8_SA
#undef PG8_SB
#undef PG8_STAGE
#undef PG8_LDA
#undef PG8_LDB
#undef PG8_MMA
#undef PG8_WAIT_V
#undef PG8_WAIT_L
#undef PG8_BAR
#undef PG8_SCHED
}
}

constexpr int NWAVES = 8, NTHR = NWAVES * 64;
constexpr int DM = 2048, NB = 4, SEQ = 2048, MROWS = NB * SEQ;
constexpr int WP = 1024, WL = 1024, NZ = 4096;
constexpr int CHUNK = 128, NCHUNK = SEQ / CHUNK;
constexpr float EPS = 1e-6f;
constexpr int KC_MOD = 8;

constexpr size_t MiB = 1u << 20;
constexpr size_t WS_MODP = 1 * MiB;
constexpr size_t WS_GATE = 2 * MiB;
constexpr size_t WS_SLOT = 3 * MiB;
constexpr size_t WS_SP8 = 2 * MiB + 512 * 1024;
constexpr size_t WS_AGG = 4 * MiB;
constexpr size_t WS_WIN = 8 * MiB;
constexpr size_t WS_WOUT = 24 * MiB;
constexpr size_t WS_WGATE = 32 * MiB;
constexpr size_t WS_WPOOL = 34 * MiB;
constexpr size_t WS_H = 36 * MiB;
constexpr size_t WS_Z = 68 * MiB;
constexpr size_t WS_UC = 132 * MiB;
constexpr size_t WS_POOLED = 148 * MiB;
constexpr size_t WS_GT = 164 * MiB;
constexpr size_t WS_YP = 228 * MiB;
constexpr size_t WS_END = 244 * MiB;
constexpr size_t WS_HLF = WS_H, WS_HLB = WS_H + 16 * MiB, WS_PF = WS_GT + 32 * MiB, WS_PB = WS_WIN, WS_A2 = WS_GT;

constexpr int LDS_BYTES = 147456;

#define LAS __attribute__((address_space(3)))
typedef unsigned short bf16;
typedef float f32x4 __attribute__((ext_vector_type(4)));
typedef unsigned u32x4 __attribute__((ext_vector_type(4)));
typedef unsigned u32x2 __attribute__((ext_vector_type(2)));

__device__ __forceinline__ unsigned f2bf(float f) { unsigned u = __builtin_bit_cast(unsigned, f); return (u + 0x7fffu + ((u >> 16) & 1u)) >> 16; }
__device__ __forceinline__ unsigned pk2(float lo, float hi) { return pg8::cvt_pk_bf16(lo, hi); }
__device__ __forceinline__ float bflo(unsigned w) { return __builtin_bit_cast(float, w << 16); }
__device__ __forceinline__ float bfhi(unsigned w) { return __builtin_bit_cast(float, w & 0xffff0000u); }
__device__ __forceinline__ float bf1(bf16 h) { return __builtin_bit_cast(float, (unsigned)h << 16); }
__device__ __forceinline__ void unpack8(const u32x4 w, float (&f)[8]) { f[0] = bflo(w.x); f[1] = bfhi(w.x); f[2] = bflo(w.y); f[3] = bfhi(w.y); f[4] = bflo(w.z); f[5] = bfhi(w.z); f[6] = bflo(w.w); f[7] = bfhi(w.w); }
__device__ __forceinline__ u32x4 pack8(const float (&f)[8]) { u32x4 w; w.x = pk2(f[0], f[1]); w.y = pk2(f[2], f[3]); w.z = pk2(f[4], f[5]); w.w = pk2(f[6], f[7]); return w; }
__device__ __forceinline__ float wave_sum(float v) {
#pragma unroll
    for (int o = 1; o < 64; o <<= 1) v += __shfl_xor(v, o);
    return v;
}
__device__ __forceinline__ float sigmoidf_(float x) { return pg8::fsigmoid(x); }
__device__ __forceinline__ float siluf_(float x) { return x * pg8::fsigmoid(x); }

#define XB_TMO      128
#define XB_XCNT(j)  (256  + 64 * (j))
#define XB_XSUB(j)  (1280 + 64 * (j))
#define XB_XGEN(j)  (2304 + 64 * (j))
#define XB_TOP      3328
#define XB_TOPGEN   3392
#define XCD_BAR_WORDS 3456
#define XB_SPIN_CAP (1u << 18)
__device__ __forceinline__ unsigned xb_ld(unsigned* p)              { return __hip_atomic_load(p, __ATOMIC_RELAXED, __HIP_MEMORY_SCOPE_AGENT); }
__device__ __forceinline__ unsigned xb_add(unsigned* p, unsigned v) { return __hip_atomic_fetch_add(p, v, __ATOMIC_RELAXED, __HIP_MEMORY_SCOPE_AGENT); }
__device__ __forceinline__ unsigned xb_xcc_id() { return (unsigned)__builtin_amdgcn_s_getreg((3 << 11) | 20) & 0xFu; }
#define XB_SPIN(cond, bar) do { unsigned _sp = 0; while (cond) { __builtin_amdgcn_s_sleep(1); \
    if ((++_sp & 255u) == 0u) { if (xb_ld(&(bar)[XB_TMO])) break; if (_sp > XB_SPIN_CAP) { atomicAdd(&(bar)[XB_TMO], 1u); break; } } } } while (0)
struct XcdBarrier { unsigned* bar; unsigned x; volatile LAS unsigned* st; };
__device__ __forceinline__ XcdBarrier xcd_barrier_post(unsigned* bar, volatile LAS unsigned* st) {
    XcdBarrier b; b.bar = bar; b.x = xb_xcc_id(); b.st = st;
    if (threadIdx.x == 0) (void)xb_add(&bar[XB_XCNT(b.x)], 1u);
    return b;
}
__device__ __forceinline__ void xcd_barrier_complete(unsigned* bar, unsigned x, unsigned& nloc, unsigned& nx) {
    const unsigned G = gridDim.x * gridDim.y * gridDim.z;
    unsigned sum, cnt, mine, sp = 0u;
    for (;;) {
        sum = 0u; cnt = 0u; mine = 0u;
#pragma unroll
        for (unsigned j = 0; j < 16; ++j) { const unsigned c = xb_ld(&bar[XB_XCNT(j)]); sum += c; cnt += (c > 0u) ? 1u : 0u; mine = (j == x) ? c : mine; }
        if (sum == G) break;
        __builtin_amdgcn_s_sleep(1);
        if ((++sp & 255u) == 0u) { if (xb_ld(&bar[XB_TMO])) break; if (sp > XB_SPIN_CAP) { atomicAdd(&bar[XB_TMO], 1u); break; } }
    }
    nloc = mine > 0u ? mine : 1u; nx = cnt > 0u ? cnt : 1u;
}
__device__ __forceinline__ void xcd_barrier(const XcdBarrier& b) {
    asm volatile("s_waitcnt vmcnt(0)" ::: "memory");
    __syncthreads();
    if (threadIdx.x == 0) {
        unsigned* bar = b.bar;
        __builtin_amdgcn_s_waitcnt(0);
        unsigned nloc = b.st[0], nx = b.st[1];
        if (nloc == 0u) { xcd_barrier_complete(bar, b.x, nloc, nx); b.st[0] = nloc; b.st[1] = nx; }
        const unsigned old = xb_add(&bar[XB_XSUB(b.x)], 1u);
        const unsigned gen = old / nloc;
        if (old + 1u == (gen + 1u) * nloc) {
            __builtin_amdgcn_fence(__ATOMIC_RELEASE, "agent");
            asm volatile("s_waitcnt vmcnt(0)" ::: "memory");
            const unsigned og = xb_add(&bar[XB_TOP], 1u);
            const unsigned tg = og / nx;
            if (og + 1u == (tg + 1u) * nx) xb_add(&bar[XB_TOPGEN], 1u);
            else XB_SPIN(xb_ld(&bar[XB_TOPGEN]) == tg, bar);
            __builtin_amdgcn_fence(__ATOMIC_ACQUIRE, "agent");
            xb_add(&bar[XB_XGEN(b.x)], 1u);
            asm volatile("s_waitcnt vmcnt(0)" ::: "memory");
        } else {
            XB_SPIN(xb_ld(&bar[XB_XGEN(b.x)]) == gen, bar);
            __builtin_amdgcn_fence(__ATOMIC_ACQUIRE, "agent");
            asm volatile("s_waitcnt vmcnt(0)" ::: "memory");
        }
    }
    __syncthreads();
}

struct Args {
    const float* in[20]; float* out; unsigned char* ws; int ph_lo, ph_hi;
};

__device__ __forceinline__ void p0_transpose_item(const float* W, int K, int N, bf16* WT, int row_off, LAS float* scr, int item, int lane, bool gmap = false, float wscale = 1.f) {
    const int nblk = N / 32, kb = item / nblk, nb = item % nblk, k0 = 64 * kb, n0 = 32 * nb;
    float tv[32];
#pragma unroll
    for (int i = 0; i < 32; ++i) { const int kk = 2 * i + (lane >> 5); tv[i] = __builtin_nontemporal_load(W + (size_t)(k0 + kk) * N + n0 + (lane & 31)); }
#pragma unroll
    for (int i = 0; i < 32; ++i) { const int kk = 2 * i + (lane >> 5); scr[kk * 33 + (lane & 31)] = tv[i]; }
    asm volatile("s_waitcnt lgkmcnt(0)" ::: "memory");
    const int c = lane & 7;
#pragma unroll
    for (int j = 0; j < 4; ++j) { const int n = (lane >> 3) + 8 * j; const LAS float* s = scr + (8 * c) * 33 + n;
        u32x4 o; o.x = pk2(s[0 * 33] * wscale, s[1 * 33] * wscale); o.y = pk2(s[2 * 33] * wscale, s[3 * 33] * wscale); o.z = pk2(s[4 * 33] * wscale, s[5 * 33] * wscale); o.w = pk2(s[6 * 33] * wscale, s[7 * 33] * wscale);
        const int drow = gmap ? pg8::gate_row_map(n0 + n) : (n0 + n);
        *(u32x4*)(WT + (size_t)(row_off + drow) * K + k0 + 8 * c) = o; }
    asm volatile("s_waitcnt lgkmcnt(0)" ::: "memory");
}

template <int W> __device__ __forceinline__ void pool_slide_item(const bf16* Z, bf16* POOLED, int gI, int tokoct, int v) {
    constexpr int LO = W / 2, HI = W - LO - 1, NR = W + 7;
    const int c0 = gI * 256 + v * 8, row0 = tokoct * 8, t0 = row0 & (SEQ - 1);
    const bf16* zp = Z + (size_t)(row0 - t0) * NZ + c0;
    u32x4 raw[NR];
#pragma unroll
    for (int k = 0; k < NR; ++k) { int tt = t0 - LO + k; tt = tt < 0 ? 0 : (tt > SEQ - 1 ? SEQ - 1 : tt); raw[k] = *(const u32x4*)(zp + (size_t)tt * NZ); }
    float S[8] = {0.f, 0.f, 0.f, 0.f, 0.f, 0.f, 0.f, 0.f}, f[8];
#pragma unroll
    for (int k = 0; k < W; ++k) { const int tt = t0 - LO + k; const float wgt = (tt >= 0 && tt < SEQ) ? 1.f : 0.f; unpack8(raw[k], f);
#pragma unroll
        for (int e = 0; e < 8; ++e) S[e] += wgt * f[e]; }
#pragma unroll
    for (int j = 0; j < 8; ++j) {
        const int t = t0 + j, st = (t - LO) < 0 ? 0 : (t - LO), en = ((t + HI) > (SEQ - 1) ? (SEQ - 1) : (t + HI)) + 1;
        const float inv = __builtin_amdgcn_rcpf((float)(en - st));
        float o[8]; unpack8(raw[j + LO], f);
#pragma unroll
        for (int e = 0; e < 8; ++e) o[e] = S[e] * inv - f[e];
        *(u32x4*)(POOLED + (size_t)(row0 + j) * WP + c0) = pack8(o);
        if (j < 7) {
            { const int tt = t0 - LO + j + W; const float wgt = (tt >= 0 && tt < SEQ) ? 1.f : 0.f; unpack8(raw[j + W], f);
#pragma unroll
              for (int e = 0; e < 8; ++e) S[e] += wgt * f[e]; }
            { const int tt = t0 - LO + j; const float wgt = (tt >= 0 && tt < SEQ) ? 1.f : 0.f; unpack8(raw[j], f);
#pragma unroll
              for (int e = 0; e < 8; ++e) S[e] -= wgt * f[e]; }
        }
    }
}

typedef float f32x16 __attribute__((ext_vector_type(16)));
typedef short bf16x8v __attribute__((ext_vector_type(8)));
template <int DIR> __device__ __forceinline__ void gate_dir(LAS unsigned char* lds, const bf16* WGT, const float* bgate, const float* sp8t, bf16* HL, bf16* PP, float* AGG,
                                                             int tid, int lane, int wv, int hd, int row0, int b, int chunk) {
    const int r = lane & 31, h = lane >> 5, c = 32 * wv + r, mi = DIR * 4 + hd;
    bf16x8v Bf[2][16];
#pragma unroll
    for (int g = 0; g < 2; ++g) { const bf16* wrow = WGT + (size_t)(mi * 512 + pg8::gate_row_map(g * 256 + c)) * 256 + h * 8;
#pragma unroll
        for (int ks = 0; ks < 16; ++ks) Bf[g][ks] = *(const bf16x8v*)(wrow + ks * 16); }
    const float brs = bgate[mi * 512 + c] * -1.44269504f, bis = bgate[mi * 512 + 256 + c] * -1.44269504f, sp = sp8t[DIR * WL + hd * 256 + c];
    float Pc = 1.f, Hc = 0.f;
#pragma unroll 1
    for (int mi2 = 0; mi2 < 4; ++mi2) {
        int zi; asm volatile("v_mov_b32 %0, 0" : "=v"(zi));
        const int mt = DIR ? 3 - mi2 : mi2, arow = 32 * mt + r;
        f32x16 ar, ai;
#pragma unroll
        for (int q = 0; q < 16; ++q) { ar[q] = 0.f; ai[q] = 0.f; }
        LAS const unsigned char* abase = lds + arow * 512;
        const int sw = (arow & 15) + zi;
        const int hz = h + zi;
        unsigned short ub[16];
#pragma unroll
        for (int q = 0; q < 16; ++q) { const int t = 32 * mt + (q & 3) + 8 * (q >> 2) + 4 * hz; ub[q] = *(LAS const unsigned short*)(lds + t * 512 + (((c >> 3) ^ (t & 15)) << 4) + (c & 7) * 2); }
        bf16x8v Afc = *(LAS const bf16x8v*)(abase + ((h ^ sw) << 4));
#pragma unroll
        for (int ks = 0; ks < 16; ++ks) { bf16x8v Afn = Afc;
            if (ks < 15) Afn = *(LAS const bf16x8v*)(abase + (((2 * (ks + 1) + h) ^ sw) << 4));
            ar = __builtin_amdgcn_mfma_f32_32x32x16_bf16(Afc, Bf[0][ks], ar, 0, 0, 0); ai = __builtin_amdgcn_mfma_f32_32x32x16_bf16(Afc, Bf[1][ks], ai, 0, 0, 0);
            Afc = Afn; }
        float av[16], bxv[16];
#pragma unroll
        for (int q = 0; q < 16; ++q) { const float u = bf1(ub[q]);
            const float dr = 1.f + __builtin_amdgcn_exp2f(fminf(ar[q] + brs, 60.f)), di = 1.f + __builtin_amdgcn_exp2f(fminf(ai[q] + bis, 60.f));
            const float inv = __builtin_amdgcn_rcpf(dr * di), rr = inv * di, ig = inv * dr;
            const float a = __builtin_amdgcn_exp2f(rr * sp), m2 = __builtin_fmaf(-a, a, 1.f);
            av[q] = a; bxv[q] = __builtin_amdgcn_sqrtf(m2) * ig * u; }
        float Pg[4], Hg[4], Pp[4], Hp[4], cinH[4], cinP[4];
#pragma unroll
        for (int g = 0; g < 4; ++g) { float P = 1.f, H = 0.f;
#pragma unroll
            for (int jj = 0; jj < 4; ++jj) { const int q = 4 * g + (DIR ? 3 - jj : jj); H = av[q] * H + bxv[q]; P *= av[q]; bxv[q] = H; av[q] = P; }
            Pg[g] = P; Hg[g] = H; Pp[g] = __shfl_xor(P, 32); Hp[g] = __shfl_xor(H, 32); }
#pragma unroll
        for (int gg = 0; gg < 4; ++gg) { const int g = DIR ? 3 - gg : gg;
            const float P0 = h ? Pp[g] : Pg[g], H0 = h ? Hp[g] : Hg[g], P1 = h ? Pg[g] : Pp[g], H1 = h ? Hg[g] : Hp[g];
            if (DIR == 0) { const float Hca = H0 + P0 * Hc, Pca = Pc * P0; cinH[g] = h ? Hca : Hc; cinP[g] = h ? Pca : Pc; Hc = H1 + P1 * Hca; Pc = Pca * P1; }
            else          { const float Hca = H1 + P1 * Hc, Pca = Pc * P1; cinH[g] = h ? Hc : Hca; cinP[g] = h ? Pc : Pca; Hc = H0 + P0 * Hca; Pc = Pca * P0; } }
        { unsigned short* hb = (unsigned short*)HL + (size_t)(row0 + 32 * mt) * WL + hd * 256; unsigned short* pb = (unsigned short*)PP + (size_t)(row0 + 32 * mt) * WL + hd * 256;
          const int loff = 4 * hz * WL + c;
          int zo; asm volatile("v_mov_b32 %0, 0" : "=v"(zo) : "v"(cinH[0]));
          LAS unsigned short* park = (LAS unsigned short*)(lds + 65536) + ((wv * 4 + mt) * 16) * 64 + lane + zo;
#pragma unroll
          for (int q = 0; q < 16; ++q) { const int tl = (q & 3) + 8 * (q >> 2); float ho = bxv[q] + av[q] * cinH[q >> 2]; const float po = av[q] * cinP[q >> 2];
              if (DIR == 1) ho += bf1(park[q * 64]);
              const unsigned w = pg8::cvt_pk_bf16(ho, po);
              if (DIR == 0) park[q * 64] = (unsigned short)(w & 0xffffu); else (hb + tl * WL)[loff] = (unsigned short)(w & 0xffffu);
              (pb + tl * WL)[loff] = (unsigned short)(w >> 16); } }
    }
    if (h == 0) { float* ag = AGG + (size_t)(((b * NCHUNK + chunk) * 2 + DIR) * 2) * WL + hd * 256 + c; ag[0] = Pc; ag[WL] = Hc; }
}
__device__ __forceinline__ void gate_item(LAS unsigned char* lds, const bf16* UC, const bf16* WGT, const float* bgate, const float* sp8t, bf16* HLF, bf16* HLB, bf16* PF, bf16* PB, float* AGG, int it) {
    int z; asm volatile("v_mov_b32 %0, 0" : "=v"(z));
    const int tid = (int)threadIdx.x + z, lane = tid & 63, wv = __builtin_amdgcn_readfirstlane(tid >> 6);
    const int tile = it >> 2, hd = it & 3, row0 = tile * 128, b = row0 / SEQ, chunk = (row0 % SEQ) / CHUNK;
    __syncthreads();
#pragma unroll
    for (int i = 0; i < 8; ++i) { const int id = tid + NTHR * i, row = id >> 5, kc = id & 31;
        const u32x4 v = *(const u32x4*)(UC + (size_t)(row0 + row) * WL + hd * 256 + kc * 8);
        *(LAS u32x4*)(lds + row * 512 + ((kc ^ (row & 15)) << 4)) = v; }
    __syncthreads();
    gate_dir<0>(lds, WGT, bgate, sp8t, HLF, PF, AGG, tid, lane, wv, hd, row0, b, chunk);
    gate_dir<1>(lds, WGT, bgate, sp8t, HLF, PB, AGG, tid, lane, wv, hd, row0, b, chunk);
}

__global__ void __launch_bounds__(NTHR, 2) fwd_kernel(Args args) {
    extern __shared__ __attribute__((aligned(16))) unsigned char lds_raw[];
    LAS unsigned char* lds = (LAS unsigned char*)lds_raw;
    cg::grid_group grid = cg::this_grid();
    const int tid0 = threadIdx.x, wave = __builtin_amdgcn_readfirstlane(tid0 >> 6);
#define PH_IDS int _z; asm volatile("v_mov_b32 %0, 0" : "=v"(_z)); const int tid = (int)threadIdx.x + _z, lane = tid & 63; (void)lane; (void)tid;
    const int G = gridDim.x, blk = blockIdx.x;
    const int gw = blk * NWAVES + wave, NGW = G * NWAVES;
    unsigned char* ws = args.ws;
    const float* x = args.in[0]; const float* cvec = args.in[1]; const float* norm_g = args.in[2]; const float* w_ada = args.in[3]; const float* b_ada = args.in[4];
    const float* w_in = args.in[5]; const float* b_in = args.in[6]; const float* w_pool = args.in[7]; const float* b_pool = args.in[8]; const float* pool_scale = args.in[9];
    const float* conv_w = args.in[10]; const float* conv_b = args.in[11]; const float* w_gate = args.in[12]; const float* b_gate = args.in[13]; const float* lru_lambda = args.in[14];
    const float* onp_g = args.in[15]; const float* onl_g = args.in[16]; const float* w_out = args.in[17]; const float* b_out = args.in[18]; const float* fin_g = args.in[19];
    float* out = args.out;
    float* MODP = (float*)(ws + WS_MODP); float* GATE = (float*)(ws + WS_GATE); float* AGG = (float*)(ws + WS_AGG);
    bf16* WIN_T = (bf16*)(ws + WS_WIN); bf16* WOUT_T = (bf16*)(ws + WS_WOUT); bf16* WGATE_T = (bf16*)(ws + WS_WGATE); bf16* WPOOL_T = (bf16*)(ws + WS_WPOOL);
    bf16* HB = (bf16*)(ws + WS_H); bf16* Z = (bf16*)(ws + WS_Z); bf16* UC = (bf16*)(ws + WS_UC); bf16* POOLED = (bf16*)(ws + WS_POOLED);
    bf16* GT = (bf16*)(ws + WS_GT); bf16* YP = (bf16*)(ws + WS_YP);
    bf16* HLF = (bf16*)(ws + WS_HLF); bf16* HLB = (bf16*)(ws + WS_HLB); bf16* PF = (bf16*)(ws + WS_PF); bf16* PB = (bf16*)(ws + WS_PB); bf16* A2 = (bf16*)(ws + WS_A2);

    const int lo = args.ph_lo, hi = args.ph_hi;
#define IN(k) (lo <= (k) && (k) < hi)
#define SEAM(k) do { if (IN(k) && IN((k) + 1)) xcd_barrier(bar); } while (0)
    volatile LAS unsigned* MISC = (volatile LAS unsigned*)(lds + LDS_BYTES - 256);
    if (tid0 < 32) MISC[tid0] = 0u;
    __syncthreads();
    XcdBarrier bar; bar.bar = (unsigned*)ws; bar.x = 0; bar.st = MISC;
    if (hi - lo > 1) bar = xcd_barrier_post((unsigned*)ws, MISC);
    if (lo > 1000) grid.sync();

    if (IN(0)) {
        PH_IDS
        if (blk < 24 * KC_MOD) {
            const int cc = blk % 24, kc = blk / 24, kb = kc * 256 + wave * 32, col = cc * 256 + lane * 4;
            float cs[NB];
#pragma unroll
            for (int b = 0; b < NB; ++b) cs[b] = siluf_(cvec[b * DM + kb + (lane & 31)]);
            f32x4 acc[NB];
#pragma unroll
            for (int b = 0; b < NB; ++b) acc[b] = (f32x4){0.f, 0.f, 0.f, 0.f};
            const float* wp = w_ada + (size_t)kb * (3 * DM) + col;
#pragma unroll 16
            for (int i = 0; i < 32; ++i) { const f32x4 wv = __builtin_nontemporal_load((const f32x4*)(wp + (size_t)i * (3 * DM)));
#pragma unroll
                for (int b = 0; b < NB; ++b) { const float s = __shfl(cs[b], i); acc[b] += wv * s; } }
            LAS float* red = (LAS float*)lds;
#pragma unroll
            for (int b = 0; b < NB; ++b) *(LAS f32x4*)(red + (wave * NB + b) * 256 + lane * 4) = acc[b];
            __syncthreads();
#pragma unroll
            for (int e = 0; e < 2; ++e) { const int o = tid * 2 + e, b = o >> 8, cl = o & 255; float s = 0.f;
#pragma unroll
                for (int w = 0; w < NWAVES; ++w) s += red[(w * NB + b) * 256 + cl];
                MODP[(size_t)(kc * NB + b) * (3 * DM) + cc * 256 + cl] = s; }
            __syncthreads();
        }
        LAS float* scr = (LAS float*)(lds + wave * 16384);
        constexpr int I_IN = (DM / 64) * (NZ / 32), I_G1 = (256 / 64) * (512 / 32), I_P1 = (256 / 64) * (256 / 32);
        constexpr int NITEMS = I_IN + 8 * I_G1 + 4 * I_P1;
        const int nmod = (G > 24 * KC_MOD) ? 24 * KC_MOD : G;
        const int nvb = nmod + (G - nmod) * 3;
        const int nv = (blk < nmod) ? 1 : 3, v0 = (blk < nmod) ? blk : nmod + (blk - nmod) * 3;
        for (int vi = 0; vi < nv; ++vi)
            for (int it = (v0 + vi) * NWAVES + wave; it < NITEMS; it += nvb * NWAVES) {
                int r = it;
                if (r < I_IN) { p0_transpose_item(w_in, DM, NZ, WIN_T, 0, scr, r, lane); continue; } r -= I_IN;
                if (r < 8 * I_G1) { const int mi = r / I_G1; p0_transpose_item(w_gate + (size_t)mi * 256 * 512, 256, 512, WGATE_T, mi * 512, scr, r % I_G1, lane, true, -1.44269504f); continue; } r -= 8 * I_G1;
                { const int mi = r / I_P1; p0_transpose_item(w_pool + (size_t)mi * 256 * 256, 256, 256, WPOOL_T, mi * 256, scr, r % I_P1, lane); }
            }
    }
    SEAM(0);

    if (IN(1)) {
        PH_IDS
        if (blk == 0) for (int i = tid; i < 2 * WL; i += NTHR) ((float*)(ws + WS_SP8))[i] = (-8.f * 1.44269504f) * log1pf(__expf(-lru_lambda[i]));
        LAS float* cA = (LAS float*)lds; LAS float* cB = cA + DM;
        for (int rb = blk; rb < MROWS / 32; rb += G) {
            const int b = rb / (SEQ / 32);
            __syncthreads();
            { const int c0 = tid * 4; f32x4 sh = *(const f32x4*)(b_ada + c0), sc = *(const f32x4*)(b_ada + DM + c0);
#pragma unroll
              for (int kc = 0; kc < KC_MOD; ++kc) { sh += *(const f32x4*)(MODP + (size_t)(kc * NB + b) * (3 * DM) + c0); sc += *(const f32x4*)(MODP + (size_t)(kc * NB + b) * (3 * DM) + DM + c0); }
              const f32x4 ng = *(const f32x4*)(norm_g + c0);
              *(LAS f32x4*)(cA + c0) = ng * (sc + 1.f); *(LAS f32x4*)(cB + c0) = sh; }
            if (tid < 32) { const int idx = rb * 32 + tid, bb = idx / DM, cl = idx % DM; float s = b_ada[2 * DM + cl];
#pragma unroll
                for (int kc = 0; kc < KC_MOD; ++kc) s += MODP[(size_t)(kc * NB + bb) * (3 * DM) + 2 * DM + cl];
                GATE[idx] = s; }
            __syncthreads();
#pragma unroll 1
            for (int q = 0; q < 4; q += 2) {
                const int row = rb * 32 + wave * 4 + q;
                const f32x4* xr = (const f32x4*)(x + (size_t)row * DM) + lane;
                f32x4 v[2][8]; float s[2] = {0.f, 0.f};
#pragma unroll
                for (int r2 = 0; r2 < 2; ++r2)
#pragma unroll
                    for (int j = 0; j < 8; ++j) v[r2][j] = __builtin_nontemporal_load(xr + r2 * (DM / 4) + 64 * j);
#pragma unroll
                for (int r2 = 0; r2 < 2; ++r2) {
#pragma unroll
                    for (int j = 0; j < 8; ++j) s[r2] += (v[r2][j].x * v[r2][j].x + v[r2][j].y * v[r2][j].y) + (v[r2][j].z * v[r2][j].z + v[r2][j].w * v[r2][j].w);
                    const float rstd = rsqrtf(wave_sum(s[r2]) * (1.f / DM) + EPS);
                    u32x2* o8 = (u32x2*)(HB + (size_t)(row + r2) * DM) + lane;
#pragma unroll
                    for (int j = 0; j < 8; ++j) { const int c0 = (64 * j + lane) * 4; const f32x4 a = *(const LAS f32x4*)(cA + c0), bb = *(const LAS f32x4*)(cB + c0);
                        const f32x4 h = v[r2][j] * rstd * a + bb; u32x2 w; w.x = pk2(h.x, h.y); w.y = pk2(h.z, h.w); o8[64 * j] = w; }
                }
            }
        }
    }
    SEAM(1);

    if (IN(2)) {
        PH_IDS
        pg8::Gemm g{HB, WIN_T, MROWS, NZ, DM, DM, 0, 0}; pg8::StaticOrder S; S.init(MROWS, NZ, G, blk);
        pg8::EpiBf16 E{Z, NZ, b_in, nullptr};
        pg8::gemm_phase<pg8::EpiBf16, pg8::StaticOrder, true, true>(lds, g, S, E);
    }
    SEAM(2);

    if (IN(3)) {
        PH_IDS
        const int NT = G * NTHR, gtid = blk * NTHR + tid;
        for (int idx = gtid; idx < 4 * (MROWS / 8) * 32; idx += NT) {
            const int gI = idx >> 15, tokoct = (idx >> 5) & (MROWS / 8 - 1), v = idx & 31;
            if (gI == 0) pool_slide_item<2>(Z, POOLED, 0, tokoct, v);
            else if (gI == 1) pool_slide_item<4>(Z, POOLED, 1, tokoct, v);
            else if (gI == 2) pool_slide_item<8>(Z, POOLED, 2, tokoct, v);
            else pool_slide_item<16>(Z, POOLED, 3, tokoct, v);
        }
        for (int idx = gtid; idx < (MROWS / 8) * 128; idx += NT) {
            const int tokoct = idx >> 7, v = idx & 127, c0 = v * 8, row0 = tokoct * 8, t0 = row0 & (SEQ - 1);
            const bf16* zp = Z + (size_t)(row0 - t0) * NZ + WP + c0;
            u32x4 raw[11];
#pragma unroll
            for (int k = 0; k < 11; ++k) { int tt = t0 - 2 + k; tt = tt < 0 ? 0 : (tt > SEQ - 1 ? SEQ - 1 : tt); raw[k] = *(const u32x4*)(zp + (size_t)tt * NZ); }
            float cw[4][8], acc[8][8], f[8];
#pragma unroll
            for (int k = 0; k < 4; ++k) { const f32x4 w0 = *(const f32x4*)(conv_w + k * WL + c0), w1 = *(const f32x4*)(conv_w + k * WL + c0 + 4);
                cw[k][0] = w0.x; cw[k][1] = w0.y; cw[k][2] = w0.z; cw[k][3] = w0.w; cw[k][4] = w1.x; cw[k][5] = w1.y; cw[k][6] = w1.z; cw[k][7] = w1.w; }
            { const f32x4 b0 = *(const f32x4*)(conv_b + c0), b1 = *(const f32x4*)(conv_b + c0 + 4);
#pragma unroll
              for (int j = 0; j < 8; ++j) { acc[j][0] = b0.x; acc[j][1] = b0.y; acc[j][2] = b0.z; acc[j][3] = b0.w; acc[j][4] = b1.x; acc[j][5] = b1.y; acc[j][6] = b1.z; acc[j][7] = b1.w; } }
#pragma unroll
            for (int r = 0; r < 11; ++r) { const int tt = t0 - 2 + r; const float wgt = (tt >= 0 && tt < SEQ) ? 1.f : 0.f; unpack8(raw[r], f);
#pragma unroll
                for (int e = 0; e < 8; ++e) f[e] *= wgt;
#pragma unroll
                for (int k = 0; k < 4; ++k) { const int j = r - k; if (j >= 0 && j < 8) {
#pragma unroll
                    for (int e = 0; e < 8; ++e) acc[j][e] += cw[k][e] * f[e]; } } }
#pragma unroll
            for (int j = 0; j < 8; ++j) *(u32x4*)(UC + (size_t)(row0 + j) * WL + c0) = pack8(acc[j]);
        }
    }
    SEAM(3);

    if (IN(4)) {
        PH_IDS
        static_assert(CHUNK == 128, "the gate phase scans 128-token chunks");
        for (int it = blk; it < (MROWS / 128) * 4; it += G) gate_item(lds, UC, WGATE_T, b_gate, (const float*)(ws + WS_SP8), HLF, HLB, PF, PB, AGG, it);
        __syncthreads();
        { pg8::Gemm g{POOLED, WPOOL_T, MROWS, WP, 256, WP, 0, 3}; pg8::StaticOrder S; S.init(MROWS, WP, G, (blk + G / 2) % G);
          pg8::EpiBf16 E{YP, WP, b_pool, pool_scale};
          pg8::gemm_phase<pg8::EpiBf16, pg8::StaticOrder, true, true>(lds, g, S, E); }
        {
            constexpr int I_OUT = (DM / 64) * (DM / 32), NPOOL = (MROWS / 256) * (WP / 256);
            const int cpool = (blk + G / 2) % G; const bool has_idle = G > NPOOL;
            if (!has_idle || cpool >= NPOOL) {
                const int rank = has_idle ? cpool - NPOOL : blk, cnt = has_idle ? G - NPOOL : G;
                LAS float* scr = (LAS float*)(lds + wave * 16384);
                int z3; asm volatile("v_mov_b32 %0, 0" : "=v"(z3)); const int ln3 = ((int)threadIdx.x + z3) & 63;
                for (int it = rank * NWAVES + wave; it < I_OUT; it += cnt * NWAVES) p0_transpose_item(w_out, DM, DM, WOUT_T, 0, scr, it, ln3);
            }
        }
    }
    SEAM(4);

    if (IN(5)) {
        PH_IDS
        LAS float* cHf = (LAS float*)lds; LAS float* cHb = cHf + WL;
        for (int rb = blk; rb < MROWS / 32; rb += G) {
            const int b = rb / (SEQ / 32), chunk = (rb % (SEQ / 32)) / (CHUNK / 32);
            __syncthreads();
#pragma unroll 1
            for (int dir = 0; dir < 2; ++dir) {
                float pv[2][NCHUNK], hv[2][NCHUNK];
                const float* agb = AGG + (size_t)(b * NCHUNK * 4 + dir * 2) * WL + tid;
#pragma unroll
                for (int qi = 0; qi < 2; ++qi)
#pragma unroll
                    for (int jj = 0; jj < NCHUNK; ++jj) { pv[qi][jj] = agb[(size_t)jj * 4 * WL + qi * NTHR]; hv[qi][jj] = agb[(size_t)jj * 4 * WL + WL + qi * NTHR]; }
#pragma unroll
                for (int qi = 0; qi < 2; ++qi) { float Hf = 0.f, Hb = 0.f;
#pragma unroll
                    for (int jj = 0; jj < NCHUNK; ++jj) Hf = (jj < chunk) ? (hv[qi][jj] + pv[qi][jj] * Hf) : Hf;
#pragma unroll
                    for (int jj = NCHUNK - 1; jj >= 0; --jj) Hb = (jj > chunk) ? (hv[qi][jj] + pv[qi][jj] * Hb) : Hb;
                    (dir ? cHb : cHf)[tid + qi * NTHR] = dir ? Hb : Hf; }
            }
            __syncthreads();
#pragma unroll 1
            for (int q = 0; q < 4; ++q) {
                const int row = rb * 32 + wave * 4 + q;
                { float y[2][8]; float ss = 0.f;
#pragma unroll
                  for (int j = 0; j < 2; ++j) { const int c0 = (j * 64 + lane) * 8; unpack8(*(const u32x4*)(YP + (size_t)row * WP + c0), y[j]);
#pragma unroll
                      for (int e = 0; e < 8; ++e) ss += y[j][e] * y[j][e]; }
                  const float rstd = rsqrtf(wave_sum(ss) * (1.f / WP) + EPS);
#pragma unroll
                  for (int j = 0; j < 2; ++j) { const int c0 = (j * 64 + lane) * 8; float gp[8], o[8]; unpack8(*(const u32x4*)(Z + (size_t)row * NZ + 2048 + c0), gp);
                      const f32x4 g0 = *(const f32x4*)(onp_g + c0), g1 = *(const f32x4*)(onp_g + c0 + 4); const float gg[8] = {g0.x, g0.y, g0.z, g0.w, g1.x, g1.y, g1.z, g1.w};
#pragma unroll
                      for (int e = 0; e < 8; ++e) o[e] = y[j][e] * rstd * gg[e] * siluf_(gp[e]);
                      *(u32x4*)(A2 + (size_t)row * DM + c0) = pack8(o); } }
                { float y[2][8]; float ss = 0.f;
#pragma unroll
                  for (int j = 0; j < 2; ++j) { const int c0 = (j * 64 + lane) * 8; float hf[8], hb[8], pf[8], pb[8];
                      unpack8(*(const u32x4*)(HLF + (size_t)row * WL + c0), hf);
#pragma unroll
                      for (int e = 0; e < 8; ++e) hb[e] = 0.f;
                      unpack8(*(const u32x4*)(PF + (size_t)row * WL + c0), pf); unpack8(*(const u32x4*)(PB + (size_t)row * WL + c0), pb);
#pragma unroll
                      for (int e = 0; e < 8; ++e) { const float v = hf[e] + hb[e] + pf[e] * cHf[c0 + e] + pb[e] * cHb[c0 + e]; y[j][e] = v; ss += v * v; } }
                  const float rstd = rsqrtf(wave_sum(ss) * (1.f / WL) + EPS);
#pragma unroll
                  for (int j = 0; j < 2; ++j) { const int c0 = (j * 64 + lane) * 8; float gp[8], o[8]; unpack8(*(const u32x4*)(Z + (size_t)row * NZ + 3072 + c0), gp);
                      const f32x4 g0 = *(const f32x4*)(onl_g + c0), g1 = *(const f32x4*)(onl_g + c0 + 4); const float gg[8] = {g0.x, g0.y, g0.z, g0.w, g1.x, g1.y, g1.z, g1.w};
#pragma unroll
                      for (int e = 0; e < 8; ++e) o[e] = y[j][e] * rstd * gg[e] * siluf_(gp[e]);
                      *(u32x4*)(A2 + (size_t)row * DM + WP + c0) = pack8(o); } }
            }
        }
    }
    SEAM(5);

    const bool fuse_norm = (G == (MROWS / 256) * (DM / 256));
    if (IN(6)) {
        PH_IDS
        pg8::Gemm g{A2, WOUT_T, MROWS, DM, DM, DM, 0, 0}; pg8::StaticOrder S; S.init(MROWS, DM, G, blk);
        if (fuse_norm) {
            pg8::EpiResidNorm E{out, x, GATE, b_out, fin_g, DM, SEQ, (float*)(ws + WS_SLOT), (unsigned*)ws + 4096, DM / 256, EPS, MROWS};
            pg8::gemm_phase<pg8::EpiResidNorm, pg8::StaticOrder, false, true>(lds, g, S, E);
        } else {
            pg8::EpiResid E{out, x, GATE, b_out, DM, SEQ};
            pg8::gemm_phase<pg8::EpiResid, pg8::StaticOrder, false, true>(lds, g, S, E);
        }
    }
    if (!fuse_norm) SEAM(6);

    if (IN(7) && !fuse_norm) {
        PH_IDS
        for (int row = gw; row < MROWS; row += NGW) {
            f32x4* xr = (f32x4*)(out + (size_t)row * DM) + lane;
            f32x4 v[8]; float s = 0.f;
#pragma unroll
            for (int j = 0; j < 8; ++j) { v[j] = xr[64 * j]; s += (v[j].x * v[j].x + v[j].y * v[j].y) + (v[j].z * v[j].z + v[j].w * v[j].w); }
            const float rstd = rsqrtf(wave_sum(s) * (1.f / DM) + EPS);
#pragma unroll
            for (int j = 0; j < 8; ++j) { const f32x4 gg = *((const f32x4*)fin_g + 64 * j + lane); xr[64 * j] = v[j] * rstd * gg; }
        }
    }
#undef IN
#undef SEAM
}

extern "C" void kernel_launch(void* const* d_in, const int* in_sizes, int n_in, void* d_out, int out_size, void* d_ws, size_t ws_size, hipStream_t stream) {
    static int grid = 0;
    if (grid == 0) {
        if (n_in != 20 || out_size != MROWS * DM || ws_size < WS_END) { fprintf(stderr, "kernel_launch: unexpected shapes (n_in %d out %d ws %zu)\n", n_in, out_size, ws_size); grid = -1; return; }
        int dev = 0, cus = 0, per_cu = 0;
        if (hipGetDevice(&dev) != hipSuccess || hipDeviceGetAttribute(&cus, hipDeviceAttributeMultiprocessorCount, dev) != hipSuccess) { grid = -1; return; }
        if (hipFuncSetAttribute((const void*)fwd_kernel, hipFuncAttributeMaxDynamicSharedMemorySize, LDS_BYTES) != hipSuccess) { fprintf(stderr, "kernel_launch: hipFuncSetAttribute failed\n"); grid = -1; return; }
        if (hipOccupancyMaxActiveBlocksPerMultiprocessor(&per_cu, (const void*)fwd_kernel, NTHR, LDS_BYTES) != hipSuccess || per_cu < 1) { fprintf(stderr, "kernel_launch: occupancy query says %d\n", per_cu); per_cu = 1; }
        (void)hipGetLastError();
        grid = cus * 1;
        fprintf(stderr, "kernel_launch: grid %d (cus %d, per_cu %d)\n", grid, cus, per_cu);
    }
    if (grid < 0) return;
    if (hipMemsetAsync(d_ws, 0, 65536, stream) != hipSuccess) { fprintf(stderr, "kernel_launch: memset failed\n"); return; }
    Args a{};
    for (int i = 0; i < 20; ++i) a.in[i] = (const float*)d_in[i];
    a.out = (float*)d_out; a.ws = (unsigned char*)d_ws;
    constexpr int NPH = 8;
#if MK_N_LAUNCHES == 1
    a.ph_lo = 0; a.ph_hi = NPH;
    void* kargs[] = {&a};
    hipError_t e = hipLaunchCooperativeKernel((const void*)fwd_kernel, dim3(grid), dim3(NTHR), kargs, LDS_BYTES, stream);
    if (e != hipSuccess) fprintf(stderr, "cooperative launch failed: %s (grid %d)\n", hipGetErrorString(e), grid);
#else
    for (int p = 0; p < NPH; ++p) {
        const int reps = ((PROBE_MASK >> p) & 1) ? 2 : 1;
        for (int r = 0; r < reps; ++r) {
            a.ph_lo = p; a.ph_hi = p + 1;
            void* kargs[] = {&a};
            hipError_t e = hipLaunchCooperativeKernel((const void*)fwd_kernel, dim3(grid), dim3(NTHR), kargs, LDS_BYTES, stream);
            if (e != hipSuccess) { fprintf(stderr, "launch %d failed: %s\n", p, hipGetErrorString(e)); break; }
        }
    }
#endif
}
```

```cpp
#include <hip/hip_runtime.h>
#include <hip/hip_cooperative_groups.h>
#include <cstdio>
#include <cstdint>
namespace cg = cooperative_groups;

#ifndef MK_N_LAUNCHES
#define MK_N_LAUNCHES 1
#endif
#ifndef PROBE_MASK
#define PROBE_MASK 256
#endif

namespace pg8 {
#define PG8_LAS __attribute__((address_space(3)))
typedef unsigned short bf16_t;
typedef short bf16x8 __attribute__((ext_vector_type(8)));
typedef float f32x4 __attribute__((ext_vector_type(4)));
typedef unsigned u32x4 __attribute__((ext_vector_type(4)));
typedef unsigned u32x2 __attribute__((ext_vector_type(2)));
constexpr int BM = 256, BK = 64, HALF = 128, HTB = HALF * BK * 2, STAGE_BYTES = 8 * HTB, NXCD = 8, WGM = 8;

__host__ __device__ __forceinline__ int lds_byte(int r, int c) { const int st = (r >> 4) * 2 + (c >> 5), rr = r & 15, cc = c & 31, ob = rr * 64 + cc * 2; return st * 1024 + (ob ^ (((ob >> 9) & 1) << 5)); }
__host__ __device__ __forceinline__ void stage_rc(int b, int& R, int& C) { const int st = b / 1024, sb = b % 1024, swz = sb ^ (((sb >> 9) & 1) << 5); R = (st >> 1) * 16 + swz / 64; C = (st & 1) * 32 + (swz % 64) / 2; }
__host__ __device__ __forceinline__ int perm32(int rho) { const int n = rho >> 4, i = rho & 15; return 8 * (i >> 2) + 4 * n + (i & 3); }

struct Unit { int pm, pn; };
struct Gemm { const bf16_t* A; const bf16_t* Bt; int M, N, K, lda, ashift, amask; };

struct StaticOrder {
    int nM, nN, nwg, G, c;
    __host__ __device__ void init(int M, int N, int G_, int c_) { nM = M / BM; nN = N / BM; nwg = nM * nN; G = G_; c = c_; }
    __host__ __device__ bool next(int i, Unit& u) const {
        const long L = (long)i * G + c; if (L >= nwg) return false;
        int wgid = (int)L; { const int q = nwg / NXCD, r = nwg % NXCD, xcd = wgid % NXCD, off = wgid / NXCD; wgid = (xcd < r ? xcd * (q + 1) : r * (q + 1) + (xcd - r) * q) + off; }
        const int nig = WGM * nN, gid = wgid / nig, fm = gid * WGM, gsz = (nM - fm) < WGM ? (nM - fm) : WGM;
        u.pm = fm + ((wgid % nig) % gsz); u.pn = (wgid % nig) / gsz; return true;
    }
    __device__ __forceinline__ void a_ready(const Unit&) const {}
    __device__ __forceinline__ void done(const Unit&) const {}
};

__device__ __forceinline__ unsigned cvt_pk_bf16(float lo, float hi) { unsigned r; asm volatile("v_cvt_pk_bf16_f32 %0, %1, %2" : "=v"(r) : "v"(lo), "v"(hi)); return r; }

struct EpiBf16 {
    static constexpr bool PERM = true, AFTER_DRAIN = false;
    bf16_t* O; int ldc; const float* bias; const float* scale;
    __device__ __forceinline__ void operator()(const f32x4 (&acc)[2][2][4][2], const Unit& u, int wr, int wc, int fr, int fq) const {
        const int row0 = u.pm * BM + wr * 64 + fr; const int col0 = u.pn * BM + wc * 32 + 8 * fq;
        f32x4 bv[2][2], sv[2][2];
#pragma unroll
        for (int bj = 0; bj < 2; ++bj)
#pragma unroll
            for (int n = 0; n < 2; ++n) { bv[bj][n] = *(const f32x4*)(bias + col0 + bj * HALF + 4 * n); sv[bj][n] = scale ? *(const f32x4*)(scale + col0 + bj * HALF + 4 * n) : (f32x4){1.f, 1.f, 1.f, 1.f}; }
#pragma unroll
        for (int ai = 0; ai < 2; ++ai)
#pragma unroll
            for (int m = 0; m < 4; ++m) { bf16_t* rowp = O + (size_t)(row0 + ai * HALF + m * 16) * ldc + col0;
#pragma unroll
                for (int bj = 0; bj < 2; ++bj) { f32x4 v0 = (acc[ai][bj][m][0] + bv[bj][0]) * sv[bj][0], v1 = (acc[ai][bj][m][1] + bv[bj][1]) * sv[bj][1];
                    u32x4 w; w.x = cvt_pk_bf16(v0[0], v0[1]); w.y = cvt_pk_bf16(v0[2], v0[3]); w.z = cvt_pk_bf16(v1[0], v1[1]); w.w = cvt_pk_bf16(v1[2], v1[3]);
                    *(u32x4*)(rowp + bj * HALF) = w; } }
    }
};
struct EpiResid {
    static constexpr bool PERM = false, AFTER_DRAIN = false;
    float* out; const float* x; const float* gate; const float* bias; int ldc; int rows_per_batch;
    __device__ __forceinline__ void operator()(const f32x4 (&acc)[2][2][4][2], const Unit& u, int wr, int wc, int fr, int fq) const {
        const int row0 = u.pm * BM + wr * 64 + fr, col0 = u.pn * BM + wc * 32 + 4 * fq;
        const float* gp = gate + (size_t)((u.pm * BM) / rows_per_batch) * ldc;
        f32x4 bv[2][2], gv[2][2];
#pragma unroll
        for (int bj = 0; bj < 2; ++bj)
#pragma unroll
            for (int n = 0; n < 2; ++n) { bv[bj][n] = *(const f32x4*)(bias + col0 + bj * HALF + n * 16); gv[bj][n] = *(const f32x4*)(gp + col0 + bj * HALF + n * 16); }
#pragma unroll
        for (int ai = 0; ai < 2; ++ai)
#pragma unroll
            for (int m = 0; m < 4; ++m) { const size_t ro = (size_t)(row0 + ai * HALF + m * 16) * ldc + col0;
#pragma unroll
                for (int bj = 0; bj < 2; ++bj)
#pragma unroll
                    for (int n = 0; n < 2; ++n) { const f32x4 xv = *(const f32x4*)(x + ro + bj * HALF + n * 16);
                        *(f32x4*)(out + ro + bj * HALF + n * 16) = xv + gv[bj][n] * (acc[ai][bj][m][n] + bv[bj][n]); } }
    }
};

struct EpiResidNorm {
    static constexpr bool PERM = false, AFTER_DRAIN = true;
    float* out; const float* x; const float* gate; const float* bias; const float* fg; int ldc; int rows_per_batch;
    float* slots;
    unsigned* cnt;
    int nN; float eps;
    __device__ __forceinline__ void operator()(const f32x4 (&)[2][2][4][2], const Unit&, int, int, int, int) const {}
    __device__ __forceinline__ void fused(f32x4 (&acc)[2][2][4][2], const Unit& u, int wr, int wc, int fr, int fq, PG8_LAS unsigned char* lds, int wid, int lane) const {
        constexpr int LPT = 260;
        const int tid = threadIdx.x;
        PG8_LAS float* T = (PG8_LAS float*)lds;
        const int colg = u.pn * BM + 4 * lane;
        const float* gp = gate + (size_t)((u.pm * BM) / rows_per_batch) * ldc;
        const f32x4 bvec = *(const f32x4*)(bias + colg), gvec = *(const f32x4*)(gp + colg);
        f32x4 v[2][16]; float mine = 0.f;
#pragma unroll
        for (int ai = 0; ai < 2; ++ai) {
            const size_t row0 = (size_t)(u.pm * BM + ai * HALF + wid * 16);
            f32x4 xr[16];
#pragma unroll
            for (int i = 0; i < 16; ++i) xr[i] = __builtin_nontemporal_load((const f32x4*)(x + (row0 + i) * ldc + colg));
#pragma unroll
            for (int m = 0; m < 4; ++m)
#pragma unroll
                for (int bj = 0; bj < 2; ++bj)
#pragma unroll
                    for (int n = 0; n < 2; ++n) *(PG8_LAS f32x4*)(T + (64 * wr + 16 * m + fr) * LPT + 128 * bj + 32 * wc + 16 * n + 4 * fq) = acc[ai][bj][m][n];
            __syncthreads();
#pragma unroll
            for (int i = 0; i < 16; ++i) { const f32x4 a = *(const PG8_LAS f32x4*)(T + (wid * 16 + i) * LPT + 4 * lane);
                const f32x4 vv = xr[i] + gvec * (a + bvec); v[ai][i] = vv;
                float sq = (vv.x * vv.x + vv.y * vv.y) + (vv.z * vv.z + vv.w * vv.w);
#pragma unroll
                for (int o = 1; o < 64; o <<= 1) sq += __shfl_xor(sq, o);
                mine = (lane == ai * 16 + i) ? sq : mine; }
            __syncthreads();
        }
        if (lane < 32) __hip_atomic_store(slots + (size_t)u.pn * M_total() + u.pm * BM + (lane >> 4) * HALF + wid * 16 + (lane & 15), mine, __ATOMIC_RELAXED, __HIP_MEMORY_SCOPE_AGENT);
        asm volatile("s_waitcnt vmcnt(0)" ::: "memory");
        __syncthreads();
        if (tid == 0) {
            __builtin_amdgcn_fence(__ATOMIC_RELEASE, "agent");
            asm volatile("s_waitcnt vmcnt(0)" ::: "memory");
            unsigned* c = cnt + 64 * u.pm;
            (void)__hip_atomic_fetch_add(c, 1u, __ATOMIC_RELAXED, __HIP_MEMORY_SCOPE_AGENT);
            unsigned sp = 0;
            while (__hip_atomic_load(c, __ATOMIC_RELAXED, __HIP_MEMORY_SCOPE_AGENT) < (unsigned)nN) { __builtin_amdgcn_s_sleep(1); if (++sp > (1u << 22)) break; }
            __builtin_amdgcn_fence(__ATOMIC_ACQUIRE, "agent");
            asm volatile("s_waitcnt vmcnt(0)" ::: "memory");
        }
        __syncthreads();
        float rl; { float sacc = 0.f; const size_t so = (size_t)u.pm * BM + ((lane >> 4) & 1) * HALF + wid * 16 + (lane & 15);
            for (int p = 0; p < nN; ++p) sacc += __hip_atomic_load(slots + (size_t)p * M_total() + so, __ATOMIC_RELAXED, __HIP_MEMORY_SCOPE_AGENT);
            rl = rsqrtf(sacc * (1.f / (float)ldc) + eps); }
        const f32x4 fvec = *(const f32x4*)(fg + colg);
#pragma unroll
        for (int ai = 0; ai < 2; ++ai) {
            const size_t row0 = (size_t)(u.pm * BM + ai * HALF + wid * 16);
#pragma unroll
            for (int i = 0; i < 16; ++i) { const float rstd = __shfl(rl, ai * 16 + i);
                __builtin_nontemporal_store(v[ai][i] * rstd * fvec, (f32x4*)(out + (row0 + i) * ldc + colg)); }
        }
    }
    int Mtot;
    __device__ __forceinline__ size_t M_total() const { return (size_t)Mtot; }
};

__device__ __forceinline__ float fexp(float x) { return __builtin_amdgcn_exp2f(x * 1.44269504f); }
__device__ __forceinline__ float fsigmoid(float x) { return __builtin_amdgcn_rcpf(1.f + __builtin_amdgcn_exp2f(x * -1.44269504f)); }
struct SingleUnit { Unit u0;
    __device__ __forceinline__ bool next(int i, Unit& u) const { if (i != 0) return false; u = u0; return true; }
    __device__ __forceinline__ void a_ready(const Unit&) const {}
    __device__ __forceinline__ void done(const Unit&) const {}
};
__host__ __device__ __forceinline__ int gate_row_map(int e) { const int n = e >> 8, c = e & 255, hf = c >> 7, cl = c & 127; return hf * 256 + (cl >> 4) * 32 + n * 16 + (cl & 15); }
struct EpiGateScan {
    static constexpr bool PERM = false, AFTER_DRAIN = true;
    static constexpr int LP = 132;
    const bf16_t* UC; const float* bgate; const float* lam; bf16_t* HLF; bf16_t* HLB; bf16_t* PF; bf16_t* PB; float* AGG; int seq, nchunk;
    __device__ __forceinline__ void operator()(const f32x4 (&)[2][2][4][2], const Unit&, int, int, int, int) const {}
    __device__ __forceinline__ void fused(f32x4 (&acc)[2][2][4][2], const Unit& u, int wr_, int wc_, int fr_, int fq_, PG8_LAS unsigned char* lds, int wid_, int lane_) const {
        int zero; asm volatile("v_mov_b32 %0, 0" : "=v"(zero));
        const int tid = (int)threadIdx.x + zero, lane = tid & 63, wid = __builtin_amdgcn_readfirstlane(tid >> 6), wr = wid >> 2, wc = wid & 3, fr = lane & 15, fq = lane >> 4;
        const int mi = u.pn >> 1, hf = u.pn & 1, dir = mi >> 2, head = mi & 3, chbase = head * 256 + hf * 128;
        bf16_t* HL = dir ? HLB : HLF; bf16_t* PP = dir ? PB : PF;
        PG8_LAS float* Aarr = (PG8_LAS float*)lds; PG8_LAS float* Barr = Aarr + 128 * LP; PG8_LAS float* SA = Barr + 128 * LP; PG8_LAS float* SH = SA + 512;
#pragma unroll
        for (int ai = 0; ai < 2; ++ai) {
            const int grow0 = u.pm * BM + HALF * ai;
        f32x4 br[2], bi[2], sp8[2];
#pragma unroll
            for (int bj = 0; bj < 2; ++bj) { const int cl0 = 64 * bj + 16 * wc + 4 * fq;
                br[bj] = *(const f32x4*)(bgate + mi * 512 + hf * 128 + cl0) * -1.44269504f; bi[bj] = *(const f32x4*)(bgate + mi * 512 + 256 + hf * 128 + cl0) * -1.44269504f;
                sp8[bj] = *(const f32x4*)(lam + dir * 1024 + chbase + cl0); }

#pragma unroll
            for (int m = 0; m < 4; ++m) { const int rl = 64 * wr + 16 * m + fr;
#pragma unroll
                for (int bj = 0; bj < 2; ++bj) { const int cl0 = 64 * bj + 16 * wc + 4 * fq;
                    const u32x2 uw = *(const u32x2*)(UC + (size_t)(grow0 + rl) * 1024 + chbase + cl0);
                    const float uu[4] = {__builtin_bit_cast(float, uw.x << 16), __builtin_bit_cast(float, uw.x & 0xffff0000u), __builtin_bit_cast(float, uw.y << 16), __builtin_bit_cast(float, uw.y & 0xffff0000u)};
                    const f32x4 gr = acc[ai][bj][m][0] + br[bj], gi = acc[ai][bj][m][1] + bi[bj];
                    f32x4 av, bxv;
#pragma unroll
                    for (int e = 0; e < 4; ++e) {
                        const float dr = 1.f + __builtin_amdgcn_exp2f(fminf(gr[e], 60.f)), di = 1.f + __builtin_amdgcn_exp2f(fminf(gi[e], 60.f));
                        const float inv = __builtin_amdgcn_rcpf(dr * di), r = inv * di, ig = inv * dr;
                        const float a = __builtin_amdgcn_exp2f(r * sp8[bj][e]);
                        const float m2 = __builtin_fmaf(-a, a, 1.f);
                        av[e] = a; bxv[e] = __builtin_amdgcn_sqrtf(m2) * ig * uu[e]; }
                    *(PG8_LAS f32x4*)(Aarr + rl * LP + cl0) = av; *(PG8_LAS f32x4*)(Barr + rl * LP + cl0) = bxv; }
                asm volatile("" ::: "memory"); }
            __syncthreads();
            { const int cl = tid & 127, sg = tid >> 7; float h = 0.f, P = 1.f;
              PG8_LAS float* pa = Aarr + (dir ? 127 - 32 * sg : 32 * sg) * LP + cl; PG8_LAS float* pb = Barr + (dir ? 127 - 32 * sg : 32 * sg) * LP + cl; const int st = dir ? -LP : LP;
              float va[32], vb[32];
#pragma unroll
              for (int k = 0; k < 32; ++k) { va[k] = pa[k * st]; vb[k] = pb[k * st]; }
#pragma unroll
              for (int k = 0; k < 32; ++k) { h = va[k] * h + vb[k]; P *= va[k]; va[k] = P; vb[k] = h; }
              SA[sg * 128 + cl] = P; SH[sg * 128 + cl] = h;
              __syncthreads();
              float cin = 0.f, pp = 1.f;
#pragma unroll
              for (int s2 = 0; s2 < 3; ++s2) { const float Ps = SA[s2 * 128 + cl], Hs = SH[s2 * 128 + cl]; if (s2 < sg) { cin = Hs + Ps * cin; pp *= Ps; } }
#pragma unroll
              for (int k = 0; k < 32; ++k) { pb[k * st] = vb[k] + va[k] * cin; pa[k * st] = va[k] * pp; } }
            __syncthreads();
#pragma unroll 1
            for (int k = 0; k < 4; ++k) { const int item = tid + 512 * k, o = item & 15, rl = item >> 4, p = dir ? 127 - rl : rl;
                const f32x4 a0 = *(const PG8_LAS f32x4*)(Aarr + rl * LP + 8 * o), a1 = *(const PG8_LAS f32x4*)(Aarr + rl * LP + 8 * o + 4);
                const f32x4 h0 = *(const PG8_LAS f32x4*)(Barr + rl * LP + 8 * o), h1 = *(const PG8_LAS f32x4*)(Barr + rl * LP + 8 * o + 4);
                const size_t go = (size_t)(grow0 + rl) * 1024 + chbase + 8 * o;
                u32x4 wh, wp; wh.x = cvt_pk_bf16(h0[0], h0[1]); wh.y = cvt_pk_bf16(h0[2], h0[3]); wh.z = cvt_pk_bf16(h1[0], h1[1]); wh.w = cvt_pk_bf16(h1[2], h1[3]);
                wp.x = cvt_pk_bf16(a0[0], a0[1]); wp.y = cvt_pk_bf16(a0[2], a0[3]); wp.z = cvt_pk_bf16(a1[0], a1[1]); wp.w = cvt_pk_bf16(a1[2], a1[3]);
                *(u32x4*)(HL + go) = wh; *(u32x4*)(PP + go) = wp;
                if (p == 127) { const int b = grow0 / seq, chunk = (grow0 % seq) / HALF;
                    float* ag = AGG + (size_t)(((b * nchunk + chunk) * 2 + dir) * 2) * 1024 + chbase + 8 * o;
                    *(f32x4*)(ag) = a0; *(f32x4*)(ag + 4) = a1; *(f32x4*)(ag + 1024) = h0; *(f32x4*)(ag + 1028) = h1; }
            }
            __syncthreads();
        }
    }
};

template <class Epi, class Sched, bool ALIGN_EPI = false, bool SP2 = false>
__device__ __forceinline__ void gemm_phase(PG8_LAS unsigned char* lds, const Gemm g, const Sched& S, const Epi& E) {
    int zero_; asm volatile("v_mov_b32 %0, 0" : "=v"(zero_));
    const int tid = (int)threadIdx.x + zero_, wid = __builtin_amdgcn_readfirstlane(tid >> 6), lane = tid & 63, wr = wid >> 2, wc = wid & 3, fr = lane & 15, fq = lane >> 4;
    const int K = g.K, nt = K / BK, lda = g.lda;
    unsigned voffA[2], voffB[2];
#pragma unroll
    for (int i = 0; i < 2; ++i) { int R, C; stage_rc(tid * 16 + i * 8192, R, C); const int Rb = Epi::PERM ? ((R & ~31) + perm32(R & 31)) : R;
        voffA[i] = (unsigned)(R * lda + C) * 2u; voffB[i] = (unsigned)(Rb * K + C) * 2u; }
    const size_t kstep = (size_t)(BK * 2);
    const size_t hsA = (size_t)HALF * lda * 2, hsB = (size_t)HALF * K * 2;
    const size_t tsA = 2 * hsA, tsB = 2 * hsB;
    const unsigned ldsw = (unsigned)wid * 1024u;
    const int aoff = lds_byte(wr * 64 + fr, fq * 8), boff = lds_byte(wc * 32 + fr, fq * 8);
#define PG8_SA(b, h) (((b) * 2 + (h)) * HTB)
#define PG8_SB(b, h) ((4 + (b) * 2 + (h)) * HTB)
#define PG8_STAGE(bufoff, gbase, voff) do { _Pragma("unroll") for (int _i = 0; _i < 2; ++_i) \
        __builtin_amdgcn_global_load_lds((const unsigned*)((const char*)(gbase) + (voff)[_i]), (PG8_LAS unsigned*)(lds + (bufoff) + ldsw + _i * 8192), 16, 0, 0); } while (0)
#define PG8_LDA(dst, b, h) do { _Pragma("unroll") for (int m = 0; m < 4; ++m) _Pragma("unroll") for (int k = 0; k < 2; ++k) dst[m][k] = *(const PG8_LAS bf16x8*)(lds + PG8_SA(b, h) + aoff + m * 2048 + k * 1024); } while (0)
#define PG8_LDB(dst, b, h) do { _Pragma("unroll") for (int n = 0; n < 2; ++n) _Pragma("unroll") for (int k = 0; k < 2; ++k) dst[n][k] = *(const PG8_LAS bf16x8*)(lds + PG8_SB(b, h) + boff + n * 2048 + k * 1024); } while (0)
#define PG8_MMA(ai, bj, At, Bt) do { __builtin_amdgcn_s_setprio(1); _Pragma("unroll") for (int m = 0; m < 4; ++m) _Pragma("unroll") for (int n = 0; n < 2; ++n) _Pragma("unroll") for (int k = 0; k < 2; ++k) \
        acc[ai][bj][m][n] = __builtin_amdgcn_mfma_f32_16x16x32_bf16(Bt[n][k], At[m][k], acc[ai][bj][m][n], 0, 0, 0); __builtin_amdgcn_s_setprio(0); } while (0)
#define PG8_WAIT_V(n) asm volatile("s_waitcnt vmcnt(" #n ")" ::: "memory")
#define PG8_WAIT_L(n) asm volatile("s_waitcnt lgkmcnt(" #n ")" ::: "memory")
#define PG8_BAR __builtin_amdgcn_s_barrier()
#define PG8_SCHED __builtin_amdgcn_sched_barrier(0)
#define PG8_APTR(u) ((const char*)g.A + (size_t)(u).pm * tsA + (size_t)((((u).pn >> g.ashift) & g.amask) * K) * 2)
    Unit cur, nxt; int ui = 0;
    if (!S.next(0, cur)) return;
    f32x4 acc[2][2][4][2];
#pragma unroll
    for (int a = 0; a < 2; ++a)
#pragma unroll
        for (int b = 0; b < 2; ++b)
#pragma unroll
            for (int m = 0; m < 4; ++m)
#pragma unroll
                for (int n = 0; n < 2; ++n) acc[a][b][m][n] = (f32x4){0.f, 0.f, 0.f, 0.f};
    bf16x8 At[4][2], B0[2][2], B1[2][2];
    const char* cA = PG8_APTR(cur); const char* cB = (const char*)g.Bt + (size_t)cur.pn * tsB;
    S.a_ready(cur);
    if constexpr (SP2) {
        PG8_STAGE(PG8_SB(0, 0), cB, voffB); PG8_STAGE(PG8_SB(0, 1), cB + hsB, voffB); PG8_STAGE(PG8_SA(0, 0), cA, voffA); PG8_STAGE(PG8_SA(0, 1), cA + hsA, voffA);
        if (wr == 1) PG8_BAR;
        PG8_WAIT_V(2); PG8_BAR;
        PG8_STAGE(PG8_SB(1, 0), cB + kstep, voffB); PG8_STAGE(PG8_SA(1, 0), cA + kstep, voffA); PG8_STAGE(PG8_SB(1, 1), cB + hsB + kstep, voffB);
        PG8_WAIT_V(6); PG8_BAR;
    } else {
        PG8_STAGE(PG8_SB(0, 0), cB, voffB); PG8_STAGE(PG8_SA(0, 0), cA, voffA); PG8_STAGE(PG8_SB(0, 1), cB + hsB, voffB); PG8_STAGE(PG8_SA(0, 1), cA + hsA, voffA);
        if (wr == 1) PG8_BAR;
        PG8_WAIT_V(4); PG8_BAR;
        PG8_STAGE(PG8_SB(1, 0), cB + kstep, voffB); PG8_STAGE(PG8_SA(1, 0), cA + kstep, voffA); PG8_STAGE(PG8_SB(1, 1), cB + hsB + kstep, voffB);
        PG8_WAIT_V(6); PG8_BAR;
    }
    for (;;) {
        const bool has_next = S.next(ui + 1, nxt);
        const char* nA = has_next ? PG8_APTR(nxt) : cA; const char* nB = has_next ? (const char*)g.Bt + (size_t)nxt.pn * tsB : cB;
        for (int t = 0; t < nt; t += 2) {
            const bool last = (t == nt - 2);
            const char* a1 = cA + (size_t)(t + 1) * kstep;
            const char* a2 = last ? nA : cA + (size_t)(t + 2) * kstep; const char* b2 = last ? nB : cB + (size_t)(t + 2) * kstep;
            const char* a3 = a2 + kstep; const char* b3 = b2 + kstep;
            if (last && has_next) S.a_ready(nxt);
            if constexpr (SP2) {
            PG8_LDB(B0, 0, 0); PG8_LDB(B1, 0, 1); PG8_SCHED; PG8_LDA(At, 0, 0); PG8_STAGE(PG8_SA(1, 1), a1 + hsA, voffA);
            PG8_WAIT_V(8); PG8_WAIT_L(0); PG8_BAR; PG8_MMA(0, 0, At, B0); PG8_MMA(0, 1, At, B1); PG8_BAR; PG8_SCHED;
            PG8_LDA(At, 0, 1); PG8_STAGE(PG8_SB(0, 0), b2, voffB); PG8_STAGE(PG8_SB(0, 1), b2 + hsB, voffB); PG8_STAGE(PG8_SA(0, 0), a2, voffA);
            PG8_WAIT_V(8); PG8_WAIT_L(0); PG8_BAR; PG8_MMA(1, 0, At, B0); PG8_MMA(1, 1, At, B1); PG8_BAR; PG8_SCHED;
            PG8_LDB(B0, 1, 0); PG8_LDB(B1, 1, 1); PG8_SCHED; PG8_LDA(At, 1, 0); PG8_STAGE(PG8_SA(0, 1), a2 + hsA, voffA);
            PG8_WAIT_V(8); PG8_WAIT_L(0); PG8_BAR; PG8_MMA(0, 0, At, B0); PG8_MMA(0, 1, At, B1); PG8_BAR; PG8_SCHED;
            PG8_LDA(At, 1, 1); PG8_STAGE(PG8_SB(1, 0), b3, voffB); PG8_STAGE(PG8_SB(1, 1), b3 + hsB, voffB); PG8_STAGE(PG8_SA(1, 0), a3, voffA);
            PG8_WAIT_V(8); PG8_WAIT_L(0); PG8_BAR; PG8_MMA(1, 0, At, B0); PG8_MMA(1, 1, At, B1); PG8_BAR; PG8_SCHED;
            } else {
            PG8_LDB(B0, 0, 0); PG8_SCHED; PG8_LDA(At, 0, 0); PG8_STAGE(PG8_SA(1, 1), a1 + hsA, voffA);
            PG8_WAIT_L(8); PG8_BAR; PG8_WAIT_L(0); PG8_MMA(0, 0, At, B0); PG8_BAR; PG8_SCHED;
            PG8_LDB(B1, 0, 1); PG8_STAGE(PG8_SB(0, 0), b2, voffB);
            PG8_BAR; PG8_WAIT_L(0); PG8_MMA(0, 1, At, B1); PG8_BAR;
            PG8_LDA(At, 0, 1); PG8_STAGE(PG8_SA(0, 0), a2, voffA);
            PG8_BAR; PG8_WAIT_L(0); PG8_MMA(1, 0, At, B0); PG8_BAR; PG8_SCHED;
            PG8_STAGE(PG8_SB(0, 1), b2 + hsB, voffB);
            PG8_WAIT_V(6); PG8_BAR; PG8_MMA(1, 1, At, B1); PG8_BAR;
            PG8_LDB(B0, 1, 0); PG8_SCHED; PG8_LDA(At, 1, 0); PG8_STAGE(PG8_SA(0, 1), a2 + hsA, voffA);
            PG8_WAIT_L(8); PG8_BAR; PG8_WAIT_L(0); PG8_MMA(0, 0, At, B0); PG8_BAR; PG8_SCHED;
            PG8_LDB(B1, 1, 1); PG8_STAGE(PG8_SB(1, 0), b3, voffB);
            PG8_BAR; PG8_WAIT_L(0); PG8_MMA(0, 1, At, B1); PG8_BAR;
            PG8_LDA(At, 1, 1); PG8_STAGE(PG8_SA(1, 0), a3, voffA);
            PG8_BAR; PG8_WAIT_L(0); PG8_MMA(1, 0, At, B0); PG8_BAR; PG8_SCHED;
            PG8_STAGE(PG8_SB(1, 1), b3 + hsB, voffB);
            PG8_WAIT_V(6); PG8_BAR; PG8_MMA(1, 1, At, B1); PG8_BAR;
            }
        }
        if constexpr (ALIGN_EPI) { if (wr == 0) PG8_BAR; }
        if constexpr (!Epi::AFTER_DRAIN) { E(acc, cur, wr, wc, fr, fq); S.done(cur); }
        if (!has_next) break;
#pragma unroll
        for (int a = 0; a < 2; ++a)
#pragma unroll
            for (int b = 0; b < 2; ++b)
#pragma unroll
                for (int m = 0; m < 4; ++m)
#pragma unroll
                    for (int n = 0; n < 2; ++n) acc[a][b][m][n] = (f32x4){0.f, 0.f, 0.f, 0.f};
        cur = nxt; cA = nA; cB = nB; ++ui;
        if constexpr (ALIGN_EPI) { if (wr == 1) PG8_BAR; }
    }
    PG8_WAIT_V(0);
    if constexpr (!ALIGN_EPI) { if (wr == 0) PG8_BAR; }
    PG8_BAR;
    if constexpr (Epi::AFTER_DRAIN) { E.fused(acc, cur, wr, wc, fr, fq, lds, wid, lane); S.done(cur); }
#undef PG8_APTR
#undef PG8_SA
#undef PG8_SB
#undef PG8_STAGE
#undef PG8_LDA
#undef PG8_LDB
#undef PG8_MMA
#undef PG8_WAIT_V
#undef PG8_WAIT_L
#undef PG8_BAR
#undef PG8_SCHED
}
}

constexpr int NWAVES = 8, NTHR = NWAVES * 64;
constexpr int DM = 2048, NB = 4, SEQ = 2048, MROWS = NB * SEQ;
constexpr int WP = 1024, WL = 1024, NZ = 4096;
constexpr int CHUNK = 128, NCHUNK = SEQ / CHUNK;
constexpr float EPS = 1e-6f;
constexpr int KC_MOD = 8;

constexpr size_t MiB = 1u << 20;
constexpr size_t WS_MODP = 1 * MiB;
constexpr size_t WS_GATE = 2 * MiB;
constexpr size_t WS_SLOT = 3 * MiB;
constexpr size_t WS_SP8 = 2 * MiB + 512 * 1024;
constexpr size_t WS_AGG = 4 * MiB;
constexpr size_t WS_WIN = 8 * MiB;
constexpr size_t WS_WOUT = 24 * MiB;
constexpr size_t WS_WGATE = 32 * MiB;
constexpr size_t WS_WPOOL = 34 * MiB;
constexpr size_t WS_H = 36 * MiB;
constexpr size_t WS_Z = 68 * MiB;
constexpr size_t WS_UC = 132 * MiB;
constexpr size_t WS_POOLED = 148 * MiB;
constexpr size_t WS_GT = 164 * MiB;
constexpr size_t WS_YP = 228 * MiB;
constexpr size_t WS_END = 244 * MiB;
constexpr size_t WS_HLF = WS_H, WS_HLB = WS_H + 16 * MiB, WS_PF = WS_GT + 32 * MiB, WS_PB = WS_WIN, WS_A2 = WS_GT;

constexpr int LDS_BYTES = 147456;

#define LAS __attribute__((address_space(3)))
typedef unsigned short bf16;
typedef float f32x4 __attribute__((ext_vector_type(4)));
typedef unsigned u32x4 __attribute__((ext_vector_type(4)));
typedef unsigned u32x2 __attribute__((ext_vector_type(2)));

__device__ __forceinline__ unsigned f2bf(float f) { unsigned u = __builtin_bit_cast(unsigned, f); return (u + 0x7fffu + ((u >> 16) & 1u)) >> 16; }
__device__ __forceinline__ unsigned pk2(float lo, float hi) { return pg8::cvt_pk_bf16(lo, hi); }
__device__ __forceinline__ float bflo(unsigned w) { return __builtin_bit_cast(float, w << 16); }
__device__ __forceinline__ float bfhi(unsigned w) { return __builtin_bit_cast(float, w & 0xffff0000u); }
__device__ __forceinline__ float bf1(bf16 h) { return __builtin_bit_cast(float, (unsigned)h << 16); }
__device__ __forceinline__ void unpack8(const u32x4 w, float (&f)[8]) { f[0] = bflo(w.x); f[1] = bfhi(w.x); f[2] = bflo(w.y); f[3] = bfhi(w.y); f[4] = bflo(w.z); f[5] = bfhi(w.z); f[6] = bflo(w.w); f[7] = bfhi(w.w); }
__device__ __forceinline__ u32x4 pack8(const float (&f)[8]) { u32x4 w; w.x = pk2(f[0], f[1]); w.y = pk2(f[2], f[3]); w.z = pk2(f[4], f[5]); w.w = pk2(f[6], f[7]); return w; }
__device__ __forceinline__ float wave_sum(float v) {
#pragma unroll
    for (int o = 1; o < 64; o <<= 1) v += __shfl_xor(v, o);
    return v;
}
__device__ __forceinline__ float sigmoidf_(float x) { return pg8::fsigmoid(x); }
__device__ __forceinline__ float siluf_(float x) { return x * pg8::fsigmoid(x); }

#define XB_TMO      128
#define XB_XCNT(j)  (256  + 64 * (j))
#define XB_XSUB(j)  (1280 + 64 * (j))
#define XB_XGEN(j)  (2304 + 64 * (j))
#define XB_TOP      3328
#define XB_TOPGEN   3392
#define XCD_BAR_WORDS 3456
#define XB_SPIN_CAP (1u << 18)
__device__ __forceinline__ unsigned xb_ld(unsigned* p)              { return __hip_atomic_load(p, __ATOMIC_RELAXED, __HIP_MEMORY_SCOPE_AGENT); }
__device__ __forceinline__ unsigned xb_add(unsigned* p, unsigned v) { return __hip_atomic_fetch_add(p, v, __ATOMIC_RELAXED, __HIP_MEMORY_SCOPE_AGENT); }
__device__ __forceinline__ unsigned xb_xcc_id() { return (unsigned)__builtin_amdgcn_s_getreg((3 << 11) | 20) & 0xFu; }
#define XB_SPIN(cond, bar) do { unsigned _sp = 0; while (cond) { __builtin_amdgcn_s_sleep(1); \
    if ((++_sp & 255u) == 0u) { if (xb_ld(&(bar)[XB_TMO])) break; if (_sp > XB_SPIN_CAP) { atomicAdd(&(bar)[XB_TMO], 1u); break; } } } } while (0)
struct XcdBarrier { unsigned* bar; unsigned x; volatile LAS unsigned* st; };
__device__ __forceinline__ XcdBarrier xcd_barrier_post(unsigned* bar, volatile LAS unsigned* st) {
    XcdBarrier b; b.bar = bar; b.x = xb_xcc_id(); b.st = st;
    if (threadIdx.x == 0) (void)xb_add(&bar[XB_XCNT(b.x)], 1u);
    return b;
}
__device__ __forceinline__ void xcd_barrier_complete(unsigned* bar, unsigned x, unsigned& nloc, unsigned& nx) {
    const unsigned G = gridDim.x * gridDim.y * gridDim.z;
    unsigned sum, cnt, mine, sp = 0u;
    for (;;) {
        sum = 0u; cnt = 0u; mine = 0u;
#pragma unroll
        for (unsigned j = 0; j < 16; ++j) { const unsigned c = xb_ld(&bar[XB_XCNT(j)]); sum += c; cnt += (c > 0u) ? 1u : 0u; mine = (j == x) ? c : mine; }
        if (sum == G) break;
        __builtin_amdgcn_s_sleep(1);
        if ((++sp & 255u) == 0u) { if (xb_ld(&bar[XB_TMO])) break; if (sp > XB_SPIN_CAP) { atomicAdd(&bar[XB_TMO], 1u); break; } }
    }
    nloc = mine > 0u ? mine : 1u; nx = cnt > 0u ? cnt : 1u;
}
__device__ __forceinline__ void xcd_barrier(const XcdBarrier& b) {
    asm volatile("s_waitcnt vmcnt(0)" ::: "memory");
    __syncthreads();
    if (threadIdx.x == 0) {
        unsigned* bar = b.bar;
        __builtin_amdgcn_s_waitcnt(0);
        unsigned nloc = b.st[0], nx = b.st[1];
        if (nloc == 0u) { xcd_barrier_complete(bar, b.x, nloc, nx); b.st[0] = nloc; b.st[1] = nx; }
        const unsigned old = xb_add(&bar[XB_XSUB(b.x)], 1u);
        const unsigned gen = old / nloc;
        if (old + 1u == (gen + 1u) * nloc) {
            __builtin_amdgcn_fence(__ATOMIC_RELEASE, "agent");
            asm volatile("s_waitcnt vmcnt(0)" ::: "memory");
            const unsigned og = xb_add(&bar[XB_TOP], 1u);
            const unsigned tg = og / nx;
            if (og + 1u == (tg + 1u) * nx) xb_add(&bar[XB_TOPGEN], 1u);
            else XB_SPIN(xb_ld(&bar[XB_TOPGEN]) == tg, bar);
            __builtin_amdgcn_fence(__ATOMIC_ACQUIRE, "agent");
            xb_add(&bar[XB_XGEN(b.x)], 1u);
            asm volatile("s_waitcnt vmcnt(0)" ::: "memory");
        } else {
            XB_SPIN(xb_ld(&bar[XB_XGEN(b.x)]) == gen, bar);
            __builtin_amdgcn_fence(__ATOMIC_ACQUIRE, "agent");
            asm volatile("s_waitcnt vmcnt(0)" ::: "memory");
        }
    }
    __syncthreads();
}

struct Args {
    const float* in[20]; float* out; unsigned char* ws; int ph_lo, ph_hi;
};

__device__ __forceinline__ void p0_transpose_item(const float* W, int K, int N, bf16* WT, int row_off, LAS float* scr, int item, int lane, bool gmap = false, float wscale = 1.f) {
    const int nblk = N / 32, kb = item / nblk, nb = item % nblk, k0 = 64 * kb, n0 = 32 * nb;
    float tv[32];
#pragma unroll
    for (int i = 0; i < 32; ++i) { const int kk = 2 * i + (lane >> 5); tv[i] = __builtin_nontemporal_load(W + (size_t)(k0 + kk) * N + n0 + (lane & 31)); }
#pragma unroll
    for (int i = 0; i < 32; ++i) { const int kk = 2 * i + (lane >> 5); scr[kk * 33 + (lane & 31)] = tv[i]; }
    asm volatile("s_waitcnt lgkmcnt(0)" ::: "memory");
    const int c = lane & 7;
#pragma unroll
    for (int j = 0; j < 4; ++j) { const int n = (lane >> 3) + 8 * j; const LAS float* s = scr + (8 * c) * 33 + n;
        u32x4 o; o.x = pk2(s[0 * 33] * wscale, s[1 * 33] * wscale); o.y = pk2(s[2 * 33] * wscale, s[3 * 33] * wscale); o.z = pk2(s[4 * 33] * wscale, s[5 * 33] * wscale); o.w = pk2(s[6 * 33] * wscale, s[7 * 33] * wscale);
        if (gmap) {
            const int e = n0 + n, g = e >> 8, ch = e & 255, k8 = k0 + 8 * c;
            *(u32x4*)(WT + (size_t)row_off * K + (size_t)((((g * 8 + (ch >> 5)) * 16 + (k8 >> 4)) * 64 + (ch & 31) + 32 * ((k8 >> 3) & 1)) * 8)) = o;
        } else *(u32x4*)(WT + (size_t)(row_off + n0 + n) * K + k0 + 8 * c) = o; }
    asm volatile("s_waitcnt lgkmcnt(0)" ::: "memory");
}

template <int W> __device__ __forceinline__ void pool_slide_item(const bf16* Z, bf16* POOLED, int gI, int tokoct, int v) {
    constexpr int LO = W / 2, HI = W - LO - 1, NR = W + 7;
    const int c0 = gI * 256 + v * 8, row0 = tokoct * 8, t0 = row0 & (SEQ - 1);
    const bf16* zp = Z + (size_t)(row0 - t0) * NZ + c0;
    u32x4 raw[NR];
#pragma unroll
    for (int k = 0; k < NR; ++k) { int tt = t0 - LO + k; tt = tt < 0 ? 0 : (tt > SEQ - 1 ? SEQ - 1 : tt); raw[k] = *(const u32x4*)(zp + (size_t)tt * NZ); }
    float S[8] = {0.f, 0.f, 0.f, 0.f, 0.f, 0.f, 0.f, 0.f}, f[8];
#pragma unroll
    for (int k = 0; k < W; ++k) { const int tt = t0 - LO + k; const float wgt = (tt >= 0 && tt < SEQ) ? 1.f : 0.f; unpack8(raw[k], f);
#pragma unroll
        for (int e = 0; e < 8; ++e) S[e] += wgt * f[e]; }
#pragma unroll
    for (int j = 0; j < 8; ++j) {
        const int t = t0 + j, st = (t - LO) < 0 ? 0 : (t - LO), en = ((t + HI) > (SEQ - 1) ? (SEQ - 1) : (t + HI)) + 1;
        const float inv = __builtin_amdgcn_rcpf((float)(en - st));
        float o[8]; unpack8(raw[j + LO], f);
#pragma unroll
        for (int e = 0; e < 8; ++e) o[e] = S[e] * inv - f[e];
        *(u32x4*)(POOLED + (size_t)(row0 + j) * WP + c0) = pack8(o);
        if (j < 7) {
            { const int tt = t0 - LO + j + W; const float wgt = (tt >= 0 && tt < SEQ) ? 1.f : 0.f; unpack8(raw[j + W], f);
#pragma unroll
              for (int e = 0; e < 8; ++e) S[e] += wgt * f[e]; }
            { const int tt = t0 - LO + j; const float wgt = (tt >= 0 && tt < SEQ) ? 1.f : 0.f; unpack8(raw[j], f);
#pragma unroll
              for (int e = 0; e < 8; ++e) S[e] -= wgt * f[e]; }
        }
    }
}

typedef float f32x16 __attribute__((ext_vector_type(16)));
typedef short bf16x8v __attribute__((ext_vector_type(8)));
template <int DIR> __device__ __forceinline__ void gate_dir(LAS unsigned char* lds, const bf16* WGT, const float* bgate, const float* sp8t, bf16* HL, bf16* PP, float* AGG,
                                                             int tid, int lane, int wv, int hd, int row0, int b, int chunk) {
    const int r = lane & 31, h = lane >> 5, c = 32 * wv + r, mi = DIR * 4 + hd;
    bf16x8v Bf[2][16];
#pragma unroll
    for (int g = 0; g < 2; ++g) { const bf16* wfr = WGT + (size_t)mi * 512 * 256 + (size_t)((g * 8 + wv) * 16) * 512 + lane * 8;
#pragma unroll
        for (int ks = 0; ks < 16; ++ks) Bf[g][ks] = *(const bf16x8v*)(wfr + ks * 512); }
    const float brs = bgate[mi * 512 + c] * -1.44269504f, bis = bgate[mi * 512 + 256 + c] * -1.44269504f, sp = sp8t[DIR * WL + hd * 256 + c];
    float Pc = 1.f, Hc = 0.f;
#pragma unroll 1
    for (int mi2 = 0; mi2 < 4; ++mi2) {
        int zi; asm volatile("v_mov_b32 %0, 0" : "=v"(zi));
        const int mt = DIR ? 3 - mi2 : mi2, arow = 32 * mt + r;
        f32x16 ar, ai;
#pragma unroll
        for (int q = 0; q < 16; ++q) { ar[q] = 0.f; ai[q] = 0.f; }
        LAS const unsigned char* abase = lds + arow * 528 + h * 16;
        const int hz = h + zi;
        unsigned short ub[16];
        { LAS const unsigned char* ubase = lds + (32 * mt + 4 * hz) * 528 + c * 2;
#pragma unroll
          for (int q = 0; q < 16; ++q) ub[q] = *(LAS const unsigned short*)(ubase + ((q & 3) + 8 * (q >> 2)) * 528); }
        bf16x8v Afc = *(LAS const bf16x8v*)(abase);
#pragma unroll
        for (int ks = 0; ks < 16; ++ks) { bf16x8v Afn = Afc;
            if (ks < 15) Afn = *(LAS const bf16x8v*)(abase + (ks + 1) * 32);
            ar = __builtin_amdgcn_mfma_f32_32x32x16_bf16(Afc, Bf[0][ks], ar, 0, 0, 0); ai = __builtin_amdgcn_mfma_f32_32x32x16_bf16(Afc, Bf[1][ks], ai, 0, 0, 0);
            Afc = Afn; }
        float av[16], bxv[16];
#pragma unroll
        for (int q = 0; q < 16; ++q) { const float u = bf1(ub[q]);
            const float dr = 1.f + __builtin_amdgcn_exp2f(fminf(ar[q] + brs, 60.f)), di = 1.f + __builtin_amdgcn_exp2f(fminf(ai[q] + bis, 60.f));
            const float inv = __builtin_amdgcn_rcpf(dr * di), rr = inv * di, ig = inv * dr;
            const float a = __builtin_amdgcn_exp2f(rr * sp), m2 = __builtin_fmaf(-a, a, 1.f);
            av[q] = a; bxv[q] = __builtin_amdgcn_sqrtf(m2) * ig * u; }
        float Pg[4], Hg[4], Pp[4], Hp[4], cinH[4], cinP[4];
#pragma unroll
        for (int g = 0; g < 4; ++g) { float P = 1.f, H = 0.f;
#pragma unroll
            for (int jj = 0; jj < 4; ++jj) { const int q = 4 * g + (DIR ? 3 - jj : jj); H = av[q] * H + bxv[q]; P *= av[q]; bxv[q] = H; av[q] = P; }
            Pg[g] = P; Hg[g] = H; Pp[g] = __shfl_xor(P, 32); Hp[g] = __shfl_xor(H, 32); }
#pragma unroll
        for (int gg = 0; gg < 4; ++gg) { const int g = DIR ? 3 - gg : gg;
            const float P0 = h ? Pp[g] : Pg[g], H0 = h ? Hp[g] : Hg[g], P1 = h ? Pg[g] : Pp[g], H1 = h ? Hg[g] : Hp[g];
            if (DIR == 0) { const float Hca = H0 + P0 * Hc, Pca = Pc * P0; cinH[g] = h ? Hca : Hc; cinP[g] = h ? Pca : Pc; Hc = H1 + P1 * Hca; Pc = Pca * P1; }
            else          { const float Hca = H1 + P1 * Hc, Pca = Pc * P1; cinH[g] = h ? Hc : Hca; cinP[g] = h ? Pc : Pca; Hc = H0 + P0 * Hca; Pc = Pca * P0; } }
        { unsigned short* hb = (unsigned short*)HL + (size_t)(row0 + 32 * mt) * WL + hd * 256; unsigned short* pb = (unsigned short*)PP + (size_t)(row0 + 32 * mt) * WL + hd * 256;
          const int loff = 4 * hz * WL + c;
          int zo; asm volatile("v_mov_b32 %0, 0" : "=v"(zo) : "v"(cinH[0]));
          LAS unsigned short* park = (LAS unsigned short*)(lds + 69632) + ((wv * 4 + mt) * 16) * 64 + lane + zo;
#pragma unroll
          for (int q = 0; q < 16; ++q) { const int tl = (q & 3) + 8 * (q >> 2); float ho = bxv[q] + av[q] * cinH[q >> 2]; const float po = av[q] * cinP[q >> 2];
              if (DIR == 1) ho += bf1(park[q * 64]);
              const unsigned w = pg8::cvt_pk_bf16(ho, po);
              if (DIR == 0) park[q * 64] = (unsigned short)(w & 0xffffu); else (hb + tl * WL)[loff] = (unsigned short)(w & 0xffffu);
              (pb + tl * WL)[loff] = (unsigned short)(w >> 16); } }
    }
    if (h == 0) { float* ag = AGG + (size_t)(((b * NCHUNK + chunk) * 2 + DIR) * 2) * WL + hd * 256 + c; ag[0] = Pc; ag[WL] = Hc; }
}
__device__ __forceinline__ void gate_item(LAS unsigned char* lds, const bf16* UC, const bf16* WGT, const float* bgate, const float* sp8t, bf16* HLF, bf16* HLB, bf16* PF, bf16* PB, float* AGG, int it) {
    int z; asm volatile("v_mov_b32 %0, 0" : "=v"(z));
    const int tid = (int)threadIdx.x + z, lane = tid & 63, wv = __builtin_amdgcn_readfirstlane(tid >> 6);
    const int tile = it >> 2, hd = it & 3, row0 = tile * 128, b = row0 / SEQ, chunk = (row0 % SEQ) / CHUNK;
    __syncthreads();
#pragma unroll
    for (int i = 0; i < 8; ++i) { const int id = tid + NTHR * i, row = id >> 5, kc = id & 31;
        const u32x4 v = *(const u32x4*)(UC + (size_t)(row0 + row) * WL + hd * 256 + kc * 8);
        *(LAS u32x4*)(lds + row * 528 + (kc << 4)) = v; }
    __syncthreads();
    gate_dir<0>(lds, WGT, bgate, sp8t, HLF, PF, AGG, tid, lane, wv, hd, row0, b, chunk);
    gate_dir<1>(lds, WGT, bgate, sp8t, HLF, PB, AGG, tid, lane, wv, hd, row0, b, chunk);
}

__global__ void __launch_bounds__(NTHR, 2) fwd_kernel(Args args) {
    extern __shared__ __attribute__((aligned(16))) unsigned char lds_raw[];
    LAS unsigned char* lds = (LAS unsigned char*)lds_raw;
    cg::grid_group grid = cg::this_grid();
    const int tid0 = threadIdx.x, wave = __builtin_amdgcn_readfirstlane(tid0 >> 6);
#define PH_IDS int _z; asm volatile("v_mov_b32 %0, 0" : "=v"(_z)); const int tid = (int)threadIdx.x + _z, lane = tid & 63; (void)lane; (void)tid;
    const int G = gridDim.x, blk = blockIdx.x;
    const int gw = blk * NWAVES + wave, NGW = G * NWAVES;
    unsigned char* ws = args.ws;
    const float* x = args.in[0]; const float* cvec = args.in[1]; const float* norm_g = args.in[2]; const float* w_ada = args.in[3]; const float* b_ada = args.in[4];
    const float* w_in = args.in[5]; const float* b_in = args.in[6]; const float* w_pool = args.in[7]; const float* b_pool = args.in[8]; const float* pool_scale = args.in[9];
    const float* conv_w = args.in[10]; const float* conv_b = args.in[11]; const float* w_gate = args.in[12]; const float* b_gate = args.in[13]; const float* lru_lambda = args.in[14];
    const float* onp_g = args.in[15]; const float* onl_g = args.in[16]; const float* w_out = args.in[17]; const float* b_out = args.in[18]; const float* fin_g = args.in[19];
    float* out = args.out;
    float* MODP = (float*)(ws + WS_MODP); float* GATE = (float*)(ws + WS_GATE); float* AGG = (float*)(ws + WS_AGG);
    bf16* WIN_T = (bf16*)(ws + WS_WIN); bf16* WOUT_T = (bf16*)(ws + WS_WOUT); bf16* WGATE_T = (bf16*)(ws + WS_WGATE); bf16* WPOOL_T = (bf16*)(ws + WS_WPOOL);
    bf16* HB = (bf16*)(ws + WS_H); bf16* Z = (bf16*)(ws + WS_Z); bf16* UC = (bf16*)(ws + WS_UC); bf16* POOLED = (bf16*)(ws + WS_POOLED);
    bf16* GT = (bf16*)(ws + WS_GT); bf16* YP = (bf16*)(ws + WS_YP);
    bf16* HLF = (bf16*)(ws + WS_HLF); bf16* HLB = (bf16*)(ws + WS_HLB); bf16* PF = (bf16*)(ws + WS_PF); bf16* PB = (bf16*)(ws + WS_PB); bf16* A2 = (bf16*)(ws + WS_A2);

    const int lo = args.ph_lo, hi = args.ph_hi;
#define IN(k) (lo <= (k) && (k) < hi)
#define SEAM(k) do { if (IN(k) && IN((k) + 1)) xcd_barrier(bar); } while (0)
    volatile LAS unsigned* MISC = (volatile LAS unsigned*)(lds + LDS_BYTES - 256);
    if (tid0 < 32) MISC[tid0] = 0u;
    __syncthreads();
    XcdBarrier bar; bar.bar = (unsigned*)ws; bar.x = 0; bar.st = MISC;
    if (hi - lo > 1) bar = xcd_barrier_post((unsigned*)ws, MISC);
    if (lo > 1000) grid.sync();

    if (IN(0)) {
        PH_IDS
        if (blk < 24 * KC_MOD) {
            const int cc = blk % 24, kc = blk / 24, kb = kc * 256 + wave * 32, col = cc * 256 + lane * 4;
            float cs[NB];
#pragma unroll
            for (int b = 0; b < NB; ++b) cs[b] = siluf_(cvec[b * DM + kb + (lane & 31)]);
            f32x4 acc[NB];
#pragma unroll
            for (int b = 0; b < NB; ++b) acc[b] = (f32x4){0.f, 0.f, 0.f, 0.f};
            const float* wp = w_ada + (size_t)kb * (3 * DM) + col;
#pragma unroll 16
            for (int i = 0; i < 32; ++i) { const f32x4 wv = __builtin_nontemporal_load((const f32x4*)(wp + (size_t)i * (3 * DM)));
#pragma unroll
                for (int b = 0; b < NB; ++b) { const float s = __shfl(cs[b], i); acc[b] += wv * s; } }
            LAS float* red = (LAS float*)lds;
#pragma unroll
            for (int b = 0; b < NB; ++b) *(LAS f32x4*)(red + (wave * NB + b) * 256 + lane * 4) = acc[b];
            __syncthreads();
#pragma unroll
            for (int e = 0; e < 2; ++e) { const int o = tid * 2 + e, b = o >> 8, cl = o & 255; float s = 0.f;
#pragma unroll
                for (int w = 0; w < NWAVES; ++w) s += red[(w * NB + b) * 256 + cl];
                MODP[(size_t)(kc * NB + b) * (3 * DM) + cc * 256 + cl] = s; }
            __syncthreads();
        }
        LAS float* scr = (LAS float*)(lds + wave * 16384);
        constexpr int I_IN = (DM / 64) * (NZ / 32), I_G1 = (256 / 64) * (512 / 32), I_P1 = (256 / 64) * (256 / 32);
        constexpr int NITEMS = I_IN + 8 * I_G1 + 4 * I_P1;
        const int nmod = (G > 24 * KC_MOD) ? 24 * KC_MOD : G;
        const int nvb = nmod + (G - nmod) * 3;
        const int nv = (blk < nmod) ? 1 : 3, v0 = (blk < nmod) ? blk : nmod + (blk - nmod) * 3;
        for (int vi = 0; vi < nv; ++vi)
            for (int it = (v0 + vi) * NWAVES + wave; it < NITEMS; it += nvb * NWAVES) {
                int r = it;
                if (r < I_IN) { p0_transpose_item(w_in, DM, NZ, WIN_T, 0, scr, r, lane); continue; } r -= I_IN;
                if (r < 8 * I_G1) { const int mi = r / I_G1; p0_transpose_item(w_gate + (size_t)mi * 256 * 512, 256, 512, WGATE_T, mi * 512, scr, r % I_G1, lane, true, -1.44269504f); continue; } r -= 8 * I_G1;
                { const int mi = r / I_P1; p0_transpose_item(w_pool + (size_t)mi * 256 * 256, 256, 256, WPOOL_T, mi * 256, scr, r % I_P1, lane); }
            }
    }
    SEAM(0);

    if (IN(1)) {
        PH_IDS
        if (blk == 0) for (int i = tid; i < 2 * WL; i += NTHR) ((float*)(ws + WS_SP8))[i] = (-8.f * 1.44269504f) * log1pf(__expf(-lru_lambda[i]));
        LAS float* cA = (LAS float*)lds; LAS float* cB = cA + DM;
        for (int rb = blk; rb < MROWS / 32; rb += G) {
            const int b = rb / (SEQ / 32);
            __syncthreads();
            { const int c0 = tid * 4; f32x4 sh = *(const f32x4*)(b_ada + c0), sc = *(const f32x4*)(b_ada + DM + c0);
#pragma unroll
              for (int kc = 0; kc < KC_MOD; ++kc) { sh += *(const f32x4*)(MODP + (size_t)(kc * NB + b) * (3 * DM) + c0); sc += *(const f32x4*)(MODP + (size_t)(kc * NB + b) * (3 * DM) + DM + c0); }
              const f32x4 ng = *(const f32x4*)(norm_g + c0);
              *(LAS f32x4*)(cA + c0) = ng * (sc + 1.f); *(LAS f32x4*)(cB + c0) = sh; }
            if (tid < 32) { const int idx = rb * 32 + tid, bb = idx / DM, cl = idx % DM; float s = b_ada[2 * DM + cl];
#pragma unroll
                for (int kc = 0; kc < KC_MOD; ++kc) s += MODP[(size_t)(kc * NB + bb) * (3 * DM) + 2 * DM + cl];
                GATE[idx] = s; }
            __syncthreads();
#pragma unroll 1
            for (int q = 0; q < 4; q += 2) {
                const int row = rb * 32 + wave * 4 + q;
                const f32x4* xr = (const f32x4*)(x + (size_t)row * DM) + lane;
                f32x4 v[2][8]; float s[2] = {0.f, 0.f};
#pragma unroll
                for (int r2 = 0; r2 < 2; ++r2)
#pragma unroll
                    for (int j = 0; j < 8; ++j) v[r2][j] = __builtin_nontemporal_load(xr + r2 * (DM / 4) + 64 * j);
#pragma unroll
                for (int r2 = 0; r2 < 2; ++r2) {
#pragma unroll
                    for (int j = 0; j < 8; ++j) s[r2] += (v[r2][j].x * v[r2][j].x + v[r2][j].y * v[r2][j].y) + (v[r2][j].z * v[r2][j].z + v[r2][j].w * v[r2][j].w);
                    const float rstd = rsqrtf(wave_sum(s[r2]) * (1.f / DM) + EPS);
                    u32x2* o8 = (u32x2*)(HB + (size_t)(row + r2) * DM) + lane;
#pragma unroll
                    for (int j = 0; j < 8; ++j) { const int c0 = (64 * j + lane) * 4; const f32x4 a = *(const LAS f32x4*)(cA + c0), bb = *(const LAS f32x4*)(cB + c0);
                        const f32x4 h = v[r2][j] * rstd * a + bb; u32x2 w; w.x = pk2(h.x, h.y); w.y = pk2(h.z, h.w); o8[64 * j] = w; }
                }
            }
        }
    }
    SEAM(1);

    if (IN(2)) {
        PH_IDS
        pg8::Gemm g{HB, WIN_T, MROWS, NZ, DM, DM, 0, 0}; pg8::StaticOrder S; S.init(MROWS, NZ, G, blk);
        pg8::EpiBf16 E{Z, NZ, b_in, nullptr};
        pg8::gemm_phase<pg8::EpiBf16, pg8::StaticOrder, true, true>(lds, g, S, E);
    }
    SEAM(2);

    if (IN(3)) {
        PH_IDS
        const int NT = G * NTHR, gtid = blk * NTHR + tid;
        for (int idx = gtid; idx < 4 * (MROWS / 8) * 32; idx += NT) {
            const int gI = idx >> 15, tokoct = (idx >> 5) & (MROWS / 8 - 1), v = idx & 31;
            if (gI == 0) pool_slide_item<2>(Z, POOLED, 0, tokoct, v);
            else if (gI == 1) pool_slide_item<4>(Z, POOLED, 1, tokoct, v);
            else if (gI == 2) pool_slide_item<8>(Z, POOLED, 2, tokoct, v);
            else pool_slide_item<16>(Z, POOLED, 3, tokoct, v);
        }
        for (int idx = gtid; idx < (MROWS / 8) * 128; idx += NT) {
            const int tokoct = idx >> 7, v = idx & 127, c0 = v * 8, row0 = tokoct * 8, t0 = row0 & (SEQ - 1);
            const bf16* zp = Z + (size_t)(row0 - t0) * NZ + WP + c0;
            u32x4 raw[11];
#pragma unroll
            for (int k = 0; k < 11; ++k) { int tt = t0 - 2 + k; tt = tt < 0 ? 0 : (tt > SEQ - 1 ? SEQ - 1 : tt); raw[k] = *(const u32x4*)(zp + (size_t)tt * NZ); }
            float cw[4][8], acc[8][8], f[8];
#pragma unroll
            for (int k = 0; k < 4; ++k) { const f32x4 w0 = *(const f32x4*)(conv_w + k * WL + c0), w1 = *(const f32x4*)(conv_w + k * WL + c0 + 4);
                cw[k][0] = w0.x; cw[k][1] = w0.y; cw[k][2] = w0.z; cw[k][3] = w0.w; cw[k][4] = w1.x; cw[k][5] = w1.y; cw[k][6] = w1.z; cw[k][7] = w1.w; }
            { const f32x4 b0 = *(const f32x4*)(conv_b + c0), b1 = *(const f32x4*)(conv_b + c0 + 4);
#pragma unroll
              for (int j = 0; j < 8; ++j) { acc[j][0] = b0.x; acc[j][1] = b0.y; acc[j][2] = b0.z; acc[j][3] = b0.w; acc[j][4] = b1.x; acc[j][5] = b1.y; acc[j][6] = b1.z; acc[j][7] = b1.w; } }
#pragma unroll
            for (int r = 0; r < 11; ++r) { const int tt = t0 - 2 + r; const float wgt = (tt >= 0 && tt < SEQ) ? 1.f : 0.f; unpack8(raw[r], f);
#pragma unroll
                for (int e = 0; e < 8; ++e) f[e] *= wgt;
#pragma unroll
                for (int k = 0; k < 4; ++k) { const int j = r - k; if (j >= 0 && j < 8) {
#pragma unroll
                    for (int e = 0; e < 8; ++e) acc[j][e] += cw[k][e] * f[e]; } } }
#pragma unroll
            for (int j = 0; j < 8; ++j) *(u32x4*)(UC + (size_t)(row0 + j) * WL + c0) = pack8(acc[j]);
        }
    }
    SEAM(3);

    if (IN(4)) {
        PH_IDS
        static_assert(CHUNK == 128, "the gate phase scans 128-token chunks");
        for (int it = blk; it < (MROWS / 128) * 4; it += G) gate_item(lds, UC, WGATE_T, b_gate, (const float*)(ws + WS_SP8), HLF, HLB, PF, PB, AGG, it);
        __syncthreads();
        { pg8::Gemm g{POOLED, WPOOL_T, MROWS, WP, 256, WP, 0, 3}; pg8::StaticOrder S; S.init(MROWS, WP, G, (blk + G / 2) % G);
          pg8::EpiBf16 E{YP, WP, b_pool, pool_scale};
          pg8::gemm_phase<pg8::EpiBf16, pg8::StaticOrder, true, true>(lds, g, S, E); }
        {
            constexpr int I_OUT = (DM / 64) * (DM / 32), NPOOL = (MROWS / 256) * (WP / 256);
            const int cpool = (blk + G / 2) % G; const bool has_idle = G > NPOOL;
            if (!has_idle || cpool >= NPOOL) {
                const int rank = has_idle ? cpool - NPOOL : blk, cnt = has_idle ? G - NPOOL : G;
                LAS float* scr = (LAS float*)(lds + wave * 16384);
                int z3; asm volatile("v_mov_b32 %0, 0" : "=v"(z3)); const int ln3 = ((int)threadIdx.x + z3) & 63;
                for (int it = rank * NWAVES + wave; it < I_OUT; it += cnt * NWAVES) p0_transpose_item(w_out, DM, DM, WOUT_T, 0, scr, it, ln3);
            }
        }
    }
    SEAM(4);

    if (IN(5)) {
        PH_IDS
        LAS float* cHf = (LAS float*)lds; LAS float* cHb = cHf + WL;
        for (int rb = blk; rb < MROWS / 32; rb += G) {
            const int b = rb / (SEQ / 32), chunk = (rb % (SEQ / 32)) / (CHUNK / 32);
            __syncthreads();
#pragma unroll 1
            for (int dir = 0; dir < 2; ++dir) {
                float pv[2][NCHUNK], hv[2][NCHUNK];
                const float* agb = AGG + (size_t)(b * NCHUNK * 4 + dir * 2) * WL + tid;
#pragma unroll
                for (int qi = 0; qi < 2; ++qi)
#pragma unroll
                    for (int jj = 0; jj < NCHUNK; ++jj) { pv[qi][jj] = agb[(size_t)jj * 4 * WL + qi * NTHR]; hv[qi][jj] = agb[(size_t)jj * 4 * WL + WL + qi * NTHR]; }
#pragma unroll
                for (int qi = 0; qi < 2; ++qi) { float Hf = 0.f, Hb = 0.f;
#pragma unroll
                    for (int jj = 0; jj < NCHUNK; ++jj) Hf = (jj < chunk) ? (hv[qi][jj] + pv[qi][jj] * Hf) : Hf;
#pragma unroll
                    for (int jj = NCHUNK - 1; jj >= 0; --jj) Hb = (jj > chunk) ? (hv[qi][jj] + pv[qi][jj] * Hb) : Hb;
                    (dir ? cHb : cHf)[tid + qi * NTHR] = dir ? Hb : Hf; }
            }
            __syncthreads();
#pragma unroll 1
            for (int q = 0; q < 4; ++q) {
                const int row = rb * 32 + wave * 4 + q;
                { float y[2][8]; float ss = 0.f;
#pragma unroll
                  for (int j = 0; j < 2; ++j) { const int c0 = (j * 64 + lane) * 8; unpack8(*(const u32x4*)(YP + (size_t)row * WP + c0), y[j]);
#pragma unroll
                      for (int e = 0; e < 8; ++e) ss += y[j][e] * y[j][e]; }
                  const float rstd = rsqrtf(wave_sum(ss) * (1.f / WP) + EPS);
#pragma unroll
                  for (int j = 0; j < 2; ++j) { const int c0 = (j * 64 + lane) * 8; float gp[8], o[8]; unpack8(*(const u32x4*)(Z + (size_t)row * NZ + 2048 + c0), gp);
                      const f32x4 g0 = *(const f32x4*)(onp_g + c0), g1 = *(const f32x4*)(onp_g + c0 + 4); const float gg[8] = {g0.x, g0.y, g0.z, g0.w, g1.x, g1.y, g1.z, g1.w};
#pragma unroll
                      for (int e = 0; e < 8; ++e) o[e] = y[j][e] * rstd * gg[e] * siluf_(gp[e]);
                      *(u32x4*)(A2 + (size_t)row * DM + c0) = pack8(o); } }
                { float y[2][8]; float ss = 0.f;
#pragma unroll
                  for (int j = 0; j < 2; ++j) { const int c0 = (j * 64 + lane) * 8; float hf[8], hb[8], pf[8], pb[8];
                      unpack8(*(const u32x4*)(HLF + (size_t)row * WL + c0), hf);
#pragma unroll
                      for (int e = 0; e < 8; ++e) hb[e] = 0.f;
                      unpack8(*(const u32x4*)(PF + (size_t)row * WL + c0), pf); unpack8(*(const u32x4*)(PB + (size_t)row * WL + c0), pb);
#pragma unroll
                      for (int e = 0; e < 8; ++e) { const float v = hf[e] + hb[e] + pf[e] * cHf[c0 + e] + pb[e] * cHb[c0 + e]; y[j][e] = v; ss += v * v; } }
                  const float rstd = rsqrtf(wave_sum(ss) * (1.f / WL) + EPS);
#pragma unroll
                  for (int j = 0; j < 2; ++j) { const int c0 = (j * 64 + lane) * 8; float gp[8], o[8]; unpack8(*(const u32x4*)(Z + (size_t)row * NZ + 3072 + c0), gp);
                      const f32x4 g0 = *(const f32x4*)(onl_g + c0), g1 = *(const f32x4*)(onl_g + c0 + 4); const float gg[8] = {g0.x, g0.y, g0.z, g0.w, g1.x, g1.y, g1.z, g1.w};
#pragma unroll
                      for (int e = 0; e < 8; ++e) o[e] = y[j][e] * rstd * gg[e] * siluf_(gp[e]);
                      *(u32x4*)(A2 + (size_t)row * DM + WP + c0) = pack8(o); } }
            }
        }
    }
    SEAM(5);

    const bool fuse_norm = (G == (MROWS / 256) * (DM / 256));
    if (IN(6)) {
        PH_IDS
        pg8::Gemm g{A2, WOUT_T, MROWS, DM, DM, DM, 0, 0}; pg8::StaticOrder S; S.init(MROWS, DM, G, blk);
        if (fuse_norm) {
            pg8::EpiResidNorm E{out, x, GATE, b_out, fin_g, DM, SEQ, (float*)(ws + WS_SLOT), (unsigned*)ws + 4096, DM / 256, EPS, MROWS};
            pg8::gemm_phase<pg8::EpiResidNorm, pg8::StaticOrder, false, true>(lds, g, S, E);
        } else {
            pg8::EpiResid E{out, x, GATE, b_out, DM, SEQ};
            pg8::gemm_phase<pg8::EpiResid, pg8::StaticOrder, false, true>(lds, g, S, E);
        }
    }
    if (!fuse_norm) SEAM(6);

    if (IN(7) && !fuse_norm) {
        PH_IDS
        for (int row = gw; row < MROWS; row += NGW) {
            f32x4* xr = (f32x4*)(out + (size_t)row * DM) + lane;
            f32x4 v[8]; float s = 0.f;
#pragma unroll
            for (int j = 0; j < 8; ++j) { v[j] = xr[64 * j]; s += (v[j].x * v[j].x + v[j].y * v[j].y) + (v[j].z * v[j].z + v[j].w * v[j].w); }
            const float rstd = rsqrtf(wave_sum(s) * (1.f / DM) + EPS);
#pragma unroll
            for (int j = 0; j < 8; ++j) { const f32x4 gg = *((const f32x4*)fin_g + 64 * j + lane); xr[64 * j] = v[j] * rstd * gg; }
        }
    }
#undef IN
#undef SEAM
}

extern "C" void kernel_launch(void* const* d_in, const int* in_sizes, int n_in, void* d_out, int out_size, void* d_ws, size_t ws_size, hipStream_t stream) {
    static int grid = 0;
    if (grid == 0) {
        if (n_in != 20 || out_size != MROWS * DM || ws_size < WS_END) { fprintf(stderr, "kernel_launch: unexpected shapes (n_in %d out %d ws %zu)\n", n_in, out_size, ws_size); grid = -1; return; }
        int dev = 0, cus = 0, per_cu = 0;
        if (hipGetDevice(&dev) != hipSuccess || hipDeviceGetAttribute(&cus, hipDeviceAttributeMultiprocessorCount, dev) != hipSuccess) { grid = -1; return; }
        if (hipFuncSetAttribute((const void*)fwd_kernel, hipFuncAttributeMaxDynamicSharedMemorySize, LDS_BYTES) != hipSuccess) { fprintf(stderr, "kernel_launch: hipFuncSetAttribute failed\n"); grid = -1; return; }
        if (hipOccupancyMaxActiveBlocksPerMultiprocessor(&per_cu, (const void*)fwd_kernel, NTHR, LDS_BYTES) != hipSuccess || per_cu < 1) { fprintf(stderr, "kernel_launch: occupancy query says %d\n", per_cu); per_cu = 1; }
        (void)hipGetLastError();
        grid = cus * 1;
        fprintf(stderr, "kernel_launch: grid %d (cus %d, per_cu %d)\n", grid, cus, per_cu);
    }
    if (grid < 0) return;
    if (hipMemsetAsync(d_ws, 0, 65536, stream) != hipSuccess) { fprintf(stderr, "kernel_launch: memset failed\n"); return; }
    Args a{};
    for (int i = 0; i < 20; ++i) a.in[i] = (const float*)d_in[i];
    a.out = (float*)d_out; a.ws = (unsigned char*)d_ws;
    constexpr int NPH = 8;
#if MK_N_LAUNCHES == 1
    a.ph_lo = 0; a.ph_hi = NPH;
    void* kargs[] = {&a};
    hipError_t e = hipLaunchCooperativeKernel((const void*)fwd_kernel, dim3(grid), dim3(NTHR), kargs, LDS_BYTES, stream);
    if (e != hipSuccess) fprintf(stderr, "cooperative launch failed: %s (grid %d)\n", hipGetErrorString(e), grid);
#else
    for (int p = 0; p < NPH; ++p) {
        const int reps = ((PROBE_MASK >> p) & 1) ? 2 : 1;
        for (int r = 0; r < reps; ++r) {
            a.ph_lo = p; a.ph_hi = p + 1;
            void* kargs[] = {&a};
            hipError_t e = hipLaunchCooperativeKernel((const void*)fwd_kernel, dim3(grid), dim3(NTHR), kargs, LDS_BYTES, stream);
            if (e != hipSuccess) { fprintf(stderr, "launch %d failed: %s\n", p, hipGetErrorString(e)); break; }
        }
    }
#endif
}
```

```cpp
#include <hip/hip_runtime.h>
#include <hip/hip_cooperative_groups.h>
#include <cstdio>
#include <cstdint>
namespace cg = cooperative_groups;

#ifndef MK_N_LAUNCHES
#define MK_N_LAUNCHES 1
#endif
#ifndef PROBE_MASK
#define PROBE_MASK 256
#endif

namespace pg8 {
#define PG8_LAS __attribute__((address_space(3)))
typedef unsigned short bf16_t;
typedef short bf16x8 __attribute__((ext_vector_type(8)));
typedef float f32x4 __attribute__((ext_vector_type(4)));
typedef unsigned u32x4 __attribute__((ext_vector_type(4)));
typedef unsigned u32x2 __attribute__((ext_vector_type(2)));
constexpr int BM = 256, BK = 64, HALF = 128, HTB = HALF * BK * 2, STAGE_BYTES = 8 * HTB, NXCD = 8, WGM = 8;

__host__ __device__ __forceinline__ int lds_byte(int r, int c) { const int st = (r >> 4) * 2 + (c >> 5), rr = r & 15, cc = c & 31, ob = rr * 64 + cc * 2; return st * 1024 + (ob ^ (((ob >> 9) & 1) << 5)); }
__host__ __device__ __forceinline__ void stage_rc(int b, int& R, int& C) { const int st = b / 1024, sb = b % 1024, swz = sb ^ (((sb >> 9) & 1) << 5); R = (st >> 1) * 16 + swz / 64; C = (st & 1) * 32 + (swz % 64) / 2; }
__host__ __device__ __forceinline__ int perm32(int rho) { const int n = rho >> 4, i = rho & 15; return 8 * (i >> 2) + 4 * n + (i & 3); }

struct Unit { int pm, pn; };
struct Gemm { const bf16_t* A; const bf16_t* Bt; int M, N, K, lda, ashift, amask; };

struct StaticOrder {
    int nM, nN, nwg, G, c;
    __host__ __device__ void init(int M, int N, int G_, int c_) { nM = M / BM; nN = N / BM; nwg = nM * nN; G = G_; c = c_; }
    __host__ __device__ bool next(int i, Unit& u) const {
        const long L = (long)i * G + c; if (L >= nwg) return false;
        int wgid = (int)L; { const int q = nwg / NXCD, r = nwg % NXCD, xcd = wgid % NXCD, off = wgid / NXCD; wgid = (xcd < r ? xcd * (q + 1) : r * (q + 1) + (xcd - r) * q) + off; }
        const int nig = WGM * nN, gid = wgid / nig, fm = gid * WGM, gsz = (nM - fm) < WGM ? (nM - fm) : WGM;
        u.pm = fm + ((wgid % nig) % gsz); u.pn = (wgid % nig) / gsz; return true;
    }
    __device__ __forceinline__ void a_ready(const Unit&) const {}
    __device__ __forceinline__ void done(const Unit&) const {}
};

__device__ __forceinline__ unsigned cvt_pk_bf16(float lo, float hi) { unsigned r; asm volatile("v_cvt_pk_bf16_f32 %0, %1, %2" : "=v"(r) : "v"(lo), "v"(hi)); return r; }

struct EpiBf16 {
    static constexpr bool PERM = true, AFTER_DRAIN = false;
    bf16_t* O; int ldc; const float* bias; const float* scale;
    __device__ __forceinline__ void operator()(const f32x4 (&acc)[2][2][4][2], const Unit& u, int wr, int wc, int fr, int fq) const {
        const int row0 = u.pm * BM + wr * 64 + fr; const int col0 = u.pn * BM + wc * 32 + 8 * fq;
        f32x4 bv[2][2], sv[2][2];
#pragma unroll
        for (int bj = 0; bj < 2; ++bj)
#pragma unroll
            for (int n = 0; n < 2; ++n) { bv[bj][n] = *(const f32x4*)(bias + col0 + bj * HALF + 4 * n); sv[bj][n] = scale ? *(const f32x4*)(scale + col0 + bj * HALF + 4 * n) : (f32x4){1.f, 1.f, 1.f, 1.f}; }
#pragma unroll
        for (int ai = 0; ai < 2; ++ai)
#pragma unroll
            for (int m = 0; m < 4; ++m) { bf16_t* rowp = O + (size_t)(row0 + ai * HALF + m * 16) * ldc + col0;
#pragma unroll
                for (int bj = 0; bj < 2; ++bj) { f32x4 v0 = (acc[ai][bj][m][0] + bv[bj][0]) * sv[bj][0], v1 = (acc[ai][bj][m][1] + bv[bj][1]) * sv[bj][1];
                    u32x4 w; w.x = cvt_pk_bf16(v0[0], v0[1]); w.y = cvt_pk_bf16(v0[2], v0[3]); w.z = cvt_pk_bf16(v1[0], v1[1]); w.w = cvt_pk_bf16(v1[2], v1[3]);
                    *(u32x4*)(rowp + bj * HALF) = w; } }
    }
};
struct EpiResid {
    static constexpr bool PERM = false, AFTER_DRAIN = false;
    float* out; const float* x; const float* gate; const float* bias; int ldc; int rows_per_batch;
    __device__ __forceinline__ void operator()(const f32x4 (&acc)[2][2][4][2], const Unit& u, int wr, int wc, int fr, int fq) const {
        const int row0 = u.pm * BM + wr * 64 + fr, col0 = u.pn * BM + wc * 32 + 4 * fq;
        const float* gp = gate + (size_t)((u.pm * BM) / rows_per_batch) * ldc;
        f32x4 bv[2][2], gv[2][2];
#pragma unroll
        for (int bj = 0; bj < 2; ++bj)
#pragma unroll
            for (int n = 0; n < 2; ++n) { bv[bj][n] = *(const f32x4*)(bias + col0 + bj * HALF + n * 16); gv[bj][n] = *(const f32x4*)(gp + col0 + bj * HALF + n * 16); }
#pragma unroll
        for (int ai = 0; ai < 2; ++ai)
#pragma unroll
            for (int m = 0; m < 4; ++m) { const size_t ro = (size_t)(row0 + ai * HALF + m * 16) * ldc + col0;
#pragma unroll
                for (int bj = 0; bj < 2; ++bj)
#pragma unroll
                    for (int n = 0; n < 2; ++n) { const f32x4 xv = *(const f32x4*)(x + ro + bj * HALF + n * 16);
                        *(f32x4*)(out + ro + bj * HALF + n * 16) = xv + gv[bj][n] * (acc[ai][bj][m][n] + bv[bj][n]); } }
    }
};

struct EpiResidNorm {
    static constexpr bool PERM = false, AFTER_DRAIN = true;
    float* out; const float* x; const float* gate; const float* bias; const float* fg; int ldc; int rows_per_batch;
    float* slots;
    unsigned* cnt;
    int nN; float eps;
    __device__ __forceinline__ void operator()(const f32x4 (&)[2][2][4][2], const Unit&, int, int, int, int) const {}
    __device__ __forceinline__ void fused(f32x4 (&acc)[2][2][4][2], const Unit& u, int wr, int wc, int fr, int fq, PG8_LAS unsigned char* lds, int wid, int lane) const {
        constexpr int LPT = 260;
        const int tid = threadIdx.x;
        PG8_LAS float* T = (PG8_LAS float*)lds;
        const int colg = u.pn * BM + 4 * lane;
        const float* gp = gate + (size_t)((u.pm * BM) / rows_per_batch) * ldc;
        const f32x4 bvec = *(const f32x4*)(bias + colg), gvec = *(const f32x4*)(gp + colg);
        f32x4 v[2][16]; float mine = 0.f;
#pragma unroll
        for (int ai = 0; ai < 2; ++ai) {
            const size_t row0 = (size_t)(u.pm * BM + ai * HALF + wid * 16);
            f32x4 xr[16];
#pragma unroll
            for (int i = 0; i < 16; ++i) xr[i] = __builtin_nontemporal_load((const f32x4*)(x + (row0 + i) * ldc + colg));
#pragma unroll
            for (int m = 0; m < 4; ++m)
#pragma unroll
                for (int bj = 0; bj < 2; ++bj)
#pragma unroll
                    for (int n = 0; n < 2; ++n) *(PG8_LAS f32x4*)(T + (64 * wr + 16 * m + fr) * LPT + 128 * bj + 32 * wc + 16 * n + 4 * fq) = acc[ai][bj][m][n];
            __syncthreads();
#pragma unroll
            for (int i = 0; i < 16; ++i) { const f32x4 a = *(const PG8_LAS f32x4*)(T + (wid * 16 + i) * LPT + 4 * lane);
                const f32x4 vv = xr[i] + gvec * (a + bvec); v[ai][i] = vv;
                float sq = (vv.x * vv.x + vv.y * vv.y) + (vv.z * vv.z + vv.w * vv.w);
#pragma unroll
                for (int o = 1; o < 64; o <<= 1) sq += __shfl_xor(sq, o);
                mine = (lane == ai * 16 + i) ? sq : mine; }
            __syncthreads();
        }
        if (lane < 32) __hip_atomic_store(slots + (size_t)u.pn * M_total() + u.pm * BM + (lane >> 4) * HALF + wid * 16 + (lane & 15), mine, __ATOMIC_RELAXED, __HIP_MEMORY_SCOPE_AGENT);
        asm volatile("s_waitcnt vmcnt(0)" ::: "memory");
        __syncthreads();
        if (tid == 0) {
            __builtin_amdgcn_fence(__ATOMIC_RELEASE, "agent");
            asm volatile("s_waitcnt vmcnt(0)" ::: "memory");
            unsigned* c = cnt + 64 * u.pm;
            (void)__hip_atomic_fetch_add(c, 1u, __ATOMIC_RELAXED, __HIP_MEMORY_SCOPE_AGENT);
            unsigned sp = 0;
            while (__hip_atomic_load(c, __ATOMIC_RELAXED, __HIP_MEMORY_SCOPE_AGENT) < (unsigned)nN) { __builtin_amdgcn_s_sleep(1); if (++sp > (1u << 22)) break; }
            __builtin_amdgcn_fence(__ATOMIC_ACQUIRE, "agent");
            asm volatile("s_waitcnt vmcnt(0)" ::: "memory");
        }
        __syncthreads();
        float rl; { float sacc = 0.f; const size_t so = (size_t)u.pm * BM + ((lane >> 4) & 1) * HALF + wid * 16 + (lane & 15);
            for (int p = 0; p < nN; ++p) sacc += __hip_atomic_load(slots + (size_t)p * M_total() + so, __ATOMIC_RELAXED, __HIP_MEMORY_SCOPE_AGENT);
            rl = rsqrtf(sacc * (1.f / (float)ldc) + eps); }
        const f32x4 fvec = *(const f32x4*)(fg + colg);
#pragma unroll
        for (int ai = 0; ai < 2; ++ai) {
            const size_t row0 = (size_t)(u.pm * BM + ai * HALF + wid * 16);
#pragma unroll
            for (int i = 0; i < 16; ++i) { const float rstd = __shfl(rl, ai * 16 + i);
                __builtin_nontemporal_store(v[ai][i] * rstd * fvec, (f32x4*)(out + (row0 + i) * ldc + colg)); }
        }
    }
    int Mtot;
    __device__ __forceinline__ size_t M_total() const { return (size_t)Mtot; }
};

__device__ __forceinline__ float fexp(float x) { return __builtin_amdgcn_exp2f(x * 1.44269504f); }
__device__ __forceinline__ float fsigmoid(float x) { return __builtin_amdgcn_rcpf(1.f + __builtin_amdgcn_exp2f(x * -1.44269504f)); }
struct SingleUnit { Unit u0;
    __device__ __forceinline__ bool next(int i, Unit& u) const { if (i != 0) return false; u = u0; return true; }
    __device__ __forceinline__ void a_ready(const Unit&) const {}
    __device__ __forceinline__ void done(const Unit&) const {}
};
__host__ __device__ __forceinline__ int gate_row_map(int e) { const int n = e >> 8, c = e & 255, hf = c >> 7, cl = c & 127; return hf * 256 + (cl >> 4) * 32 + n * 16 + (cl & 15); }
struct EpiGateScan {
    static constexpr bool PERM = false, AFTER_DRAIN = true;
    static constexpr int LP = 132;
    const bf16_t* UC; const float* bgate; const float* lam; bf16_t* HLF; bf16_t* HLB; bf16_t* PF; bf16_t* PB; float* AGG; int seq, nchunk;
    __device__ __forceinline__ void operator()(const f32x4 (&)[2][2][4][2], const Unit&, int, int, int, int) const {}
    __device__ __forceinline__ void fused(f32x4 (&acc)[2][2][4][2], const Unit& u, int wr_, int wc_, int fr_, int fq_, PG8_LAS unsigned char* lds, int wid_, int lane_) const {
        int zero; asm volatile("v_mov_b32 %0, 0" : "=v"(zero));
        const int tid = (int)threadIdx.x + zero, lane = tid & 63, wid = __builtin_amdgcn_readfirstlane(tid >> 6), wr = wid >> 2, wc = wid & 3, fr = lane & 15, fq = lane >> 4;
        const int mi = u.pn >> 1, hf = u.pn & 1, dir = mi >> 2, head = mi & 3, chbase = head * 256 + hf * 128;
        bf16_t* HL = dir ? HLB : HLF; bf16_t* PP = dir ? PB : PF;
        PG8_LAS float* Aarr = (PG8_LAS float*)lds; PG8_LAS float* Barr = Aarr + 128 * LP; PG8_LAS float* SA = Barr + 128 * LP; PG8_LAS float* SH = SA + 512;
#pragma unroll
        for (int ai = 0; ai < 2; ++ai) {
            const int grow0 = u.pm * BM + HALF * ai;
        f32x4 br[2], bi[2], sp8[2];
#pragma unroll
            for (int bj = 0; bj < 2; ++bj) { const int cl0 = 64 * bj + 16 * wc + 4 * fq;
                br[bj] = *(const f32x4*)(bgate + mi * 512 + hf * 128 + cl0) * -1.44269504f; bi[bj] = *(const f32x4*)(bgate + mi * 512 + 256 + hf * 128 + cl0) * -1.44269504f;
                sp8[bj] = *(const f32x4*)(lam + dir * 1024 + chbase + cl0); }

#pragma unroll
            for (int m = 0; m < 4; ++m) { const int rl = 64 * wr + 16 * m + fr;
#pragma unroll
                for (int bj = 0; bj < 2; ++bj) { const int cl0 = 64 * bj + 16 * wc + 4 * fq;
                    const u32x2 uw = *(const u32x2*)(UC + (size_t)(grow0 + rl) * 1024 + chbase + cl0);
                    const float uu[4] = {__builtin_bit_cast(float, uw.x << 16), __builtin_bit_cast(float, uw.x & 0xffff0000u), __builtin_bit_cast(float, uw.y << 16), __builtin_bit_cast(float, uw.y & 0xffff0000u)};
                    const f32x4 gr = acc[ai][bj][m][0] + br[bj], gi = acc[ai][bj][m][1] + bi[bj];
                    f32x4 av, bxv;
#pragma unroll
                    for (int e = 0; e < 4; ++e) {
                        const float dr = 1.f + __builtin_amdgcn_exp2f(fminf(gr[e], 60.f)), di = 1.f + __builtin_amdgcn_exp2f(fminf(gi[e], 60.f));
                        const float inv = __builtin_amdgcn_rcpf(dr * di), r = inv * di, ig = inv * dr;
                        const float a = __builtin_amdgcn_exp2f(r * sp8[bj][e]);
                        const float m2 = __builtin_fmaf(-a, a, 1.f);
                        av[e] = a; bxv[e] = __builtin_amdgcn_sqrtf(m2) * ig * uu[e]; }
                    *(PG8_LAS f32x4*)(Aarr + rl * LP + cl0) = av; *(PG8_LAS f32x4*)(Barr + rl * LP + cl0) = bxv; }
                asm volatile("" ::: "memory"); }
            __syncthreads();
            { const int cl = tid & 127, sg = tid >> 7; float h = 0.f, P = 1.f;
              PG8_LAS float* pa = Aarr + (dir ? 127 - 32 * sg : 32 * sg) * LP + cl; PG8_LAS float* pb = Barr + (dir ? 127 - 32 * sg : 32 * sg) * LP + cl; const int st = dir ? -LP : LP;
              float va[32], vb[32];
#pragma unroll
              for (int k = 0; k < 32; ++k) { va[k] = pa[k * st]; vb[k] = pb[k * st]; }
#pragma unroll
              for (int k = 0; k < 32; ++k) { h = va[k] * h + vb[k]; P *= va[k]; va[k] = P; vb[k] = h; }
              SA[sg * 128 + cl] = P; SH[sg * 128 + cl] = h;
              __syncthreads();
              float cin = 0.f, pp = 1.f;
#pragma unroll
              for (int s2 = 0; s2 < 3; ++s2) { const float Ps = SA[s2 * 128 + cl], Hs = SH[s2 * 128 + cl]; if (s2 < sg) { cin = Hs + Ps * cin; pp *= Ps; } }
#pragma unroll
              for (int k = 0; k < 32; ++k) { pb[k * st] = vb[k] + va[k] * cin; pa[k * st] = va[k] * pp; } }
            __syncthreads();
#pragma unroll 1
            for (int k = 0; k < 4; ++k) { const int item = tid + 512 * k, o = item & 15, rl = item >> 4, p = dir ? 127 - rl : rl;
                const f32x4 a0 = *(const PG8_LAS f32x4*)(Aarr + rl * LP + 8 * o), a1 = *(const PG8_LAS f32x4*)(Aarr + rl * LP + 8 * o + 4);
                const f32x4 h0 = *(const PG8_LAS f32x4*)(Barr + rl * LP + 8 * o), h1 = *(const PG8_LAS f32x4*)(Barr + rl * LP + 8 * o + 4);
                const size_t go = (size_t)(grow0 + rl) * 1024 + chbase + 8 * o;
                u32x4 wh, wp; wh.x = cvt_pk_bf16(h0[0], h0[1]); wh.y = cvt_pk_bf16(h0[2], h0[3]); wh.z = cvt_pk_bf16(h1[0], h1[1]); wh.w = cvt_pk_bf16(h1[2], h1[3]);
                wp.x = cvt_pk_bf16(a0[0], a0[1]); wp.y = cvt_pk_bf16(a0[2], a0[3]); wp.z = cvt_pk_bf16(a1[0], a1[1]); wp.w = cvt_pk_bf16(a1[2], a1[3]);
                *(u32x4*)(HL + go) = wh; *(u32x4*)(PP + go) = wp;
                if (p == 127) { const int b = grow0 / seq, chunk = (grow0 % seq) / HALF;
                    float* ag = AGG + (size_t)(((b * nchunk + chunk) * 2 + dir) * 2) * 1024 + chbase + 8 * o;
                    *(f32x4*)(ag) = a0; *(f32x4*)(ag + 4) = a1; *(f32x4*)(ag + 1024) = h0; *(f32x4*)(ag + 1028) = h1; }
            }
            __syncthreads();
        }
    }
};

template <class Epi, class Sched, bool ALIGN_EPI = false, bool SP2 = false>
__device__ __forceinline__ void gemm_phase(PG8_LAS unsigned char* lds, const Gemm g, const Sched& S, const Epi& E) {
    int zero_; asm volatile("v_mov_b32 %0, 0" : "=v"(zero_));
    const int tid = (int)threadIdx.x + zero_, wid = __builtin_amdgcn_readfirstlane(tid >> 6), lane = tid & 63, wr = wid >> 2, wc = wid & 3, fr = lane & 15, fq = lane >> 4;
    const int K = g.K, nt = K / BK, lda = g.lda;
    unsigned voffA[2], voffB[2];
#pragma unroll
    for (int i = 0; i < 2; ++i) { int R, C; stage_rc(tid * 16 + i * 8192, R, C); const int Rb = Epi::PERM ? ((R & ~31) + perm32(R & 31)) : R;
        voffA[i] = (unsigned)(R * lda + C) * 2u; voffB[i] = (unsigned)(Rb * K + C) * 2u; }
    const size_t kstep = (size_t)(BK * 2);
    const size_t hsA = (size_t)HALF * lda * 2, hsB = (size_t)HALF * K * 2;
    const size_t tsA = 2 * hsA, tsB = 2 * hsB;
    const unsigned ldsw = (unsigned)wid * 1024u;
    const int aoff = lds_byte(wr * 64 + fr, fq * 8), boff = lds_byte(wc * 32 + fr, fq * 8);
#define PG8_SA(b, h) (((b) * 2 + (h)) * HTB)
#define PG8_SB(b, h) ((4 + (b) * 2 + (h)) * HTB)
#define PG8_STAGE(bufoff, gbase, voff) do { _Pragma("unroll") for (int _i = 0; _i < 2; ++_i) \
        __builtin_amdgcn_global_load_lds((const unsigned*)((const char*)(gbase) + (voff)[_i]), (PG8_LAS unsigned*)(lds + (bufoff) + ldsw + _i * 8192), 16, 0, 0); } while (0)
#define PG8_LDA(dst, b, h) do { _Pragma("unroll") for (int m = 0; m < 4; ++m) _Pragma("unroll") for (int k = 0; k < 2; ++k) dst[m][k] = *(const PG8_LAS bf16x8*)(lds + PG8_SA(b, h) + aoff + m * 2048 + k * 1024); } while (0)
#define PG8_LDB(dst, b, h) do { _Pragma("unroll") for (int n = 0; n < 2; ++n) _Pragma("unroll") for (int k = 0; k < 2; ++k) dst[n][k] = *(const PG8_LAS bf16x8*)(lds + PG8_SB(b, h) + boff + n * 2048 + k * 1024); } while (0)
#define PG8_MMA(ai, bj, At, Bt) do { __builtin_amdgcn_s_setprio(1); _Pragma("unroll") for (int m = 0; m < 4; ++m) _Pragma("unroll") for (int n = 0; n < 2; ++n) _Pragma("unroll") for (int k = 0; k < 2; ++k) \
        acc[ai][bj][m][n] = __builtin_amdgcn_mfma_f32_16x16x32_bf16(Bt[n][k], At[m][k], acc[ai][bj][m][n], 0, 0, 0); __builtin_amdgcn_s_setprio(0); } while (0)
#define PG8_WAIT_V(n) asm volatile("s_waitcnt vmcnt(" #n ")" ::: "memory")
#define PG8_WAIT_L(n) asm volatile("s_waitcnt lgkmcnt(" #n ")" ::: "memory")
#define PG8_BAR __builtin_amdgcn_s_barrier()
#define PG8_SCHED __builtin_amdgcn_sched_barrier(0)
#define PG8_APTR(u) ((const char*)g.A + (size_t)(u).pm * tsA + (size_t)((((u).pn >> g.ashift) & g.amask) * K) * 2)
    Unit cur, nxt; int ui = 0;
    if (!S.next(0, cur)) return;
    f32x4 acc[2][2][4][2];
#pragma unroll
    for (int a = 0; a < 2; ++a)
#pragma unroll
        for (int b = 0; b < 2; ++b)
#pragma unroll
            for (int m = 0; m < 4; ++m)
#pragma unroll
                for (int n = 0; n < 2; ++n) acc[a][b][m][n] = (f32x4){0.f, 0.f, 0.f, 0.f};
    bf16x8 At[4][2], B0[2][2], B1[2][2];
    const char* cA = PG8_APTR(cur); const char* cB = (const char*)g.Bt + (size_t)cur.pn * tsB;
    S.a_ready(cur);
    if constexpr (SP2) {
        PG8_STAGE(PG8_SB(0, 0), cB, voffB); PG8_STAGE(PG8_SB(0, 1), cB + hsB, voffB); PG8_STAGE(PG8_SA(0, 0), cA, voffA); PG8_STAGE(PG8_SA(0, 1), cA + hsA, voffA);
        if (wr == 1) PG8_BAR;
        PG8_WAIT_V(2); PG8_BAR;
        PG8_STAGE(PG8_SB(1, 0), cB + kstep, voffB); PG8_STAGE(PG8_SA(1, 0), cA + kstep, voffA); PG8_STAGE(PG8_SB(1, 1), cB + hsB + kstep, voffB);
        PG8_WAIT_V(6); PG8_BAR;
    } else {
        PG8_STAGE(PG8_SB(0, 0), cB, voffB); PG8_STAGE(PG8_SA(0, 0), cA, voffA); PG8_STAGE(PG8_SB(0, 1), cB + hsB, voffB); PG8_STAGE(PG8_SA(0, 1), cA + hsA, voffA);
        if (wr == 1) PG8_BAR;
        PG8_WAIT_V(4); PG8_BAR;
        PG8_STAGE(PG8_SB(1, 0), cB + kstep, voffB); PG8_STAGE(PG8_SA(1, 0), cA + kstep, voffA); PG8_STAGE(PG8_SB(1, 1), cB + hsB + kstep, voffB);
        PG8_WAIT_V(6); PG8_BAR;
    }
    for (;;) {
        const bool has_next = S.next(ui + 1, nxt);
        const char* nA = has_next ? PG8_APTR(nxt) : cA; const char* nB = has_next ? (const char*)g.Bt + (size_t)nxt.pn * tsB : cB;
        for (int t = 0; t < nt; t += 2) {
            const bool last = (t == nt - 2);
            const char* a1 = cA + (size_t)(t + 1) * kstep;
            const char* a2 = last ? nA : cA + (size_t)(t + 2) * kstep; const char* b2 = last ? nB : cB + (size_t)(t + 2) * kstep;
            const char* a3 = a2 + kstep; const char* b3 = b2 + kstep;
            if (last && has_next) S.a_ready(nxt);
            if constexpr (SP2) {
            PG8_LDB(B0, 0, 0); PG8_LDB(B1, 0, 1); PG8_SCHED; PG8_LDA(At, 0, 0); PG8_STAGE(PG8_SA(1, 1), a1 + hsA, voffA);
            PG8_WAIT_V(8); PG8_WAIT_L(0); PG8_BAR; PG8_MMA(0, 0, At, B0); PG8_MMA(0, 1, At, B1); PG8_BAR; PG8_SCHED;
            PG8_LDA(At, 0, 1); PG8_STAGE(PG8_SB(0, 0), b2, voffB); PG8_STAGE(PG8_SB(0, 1), b2 + hsB, voffB); PG8_STAGE(PG8_SA(0, 0), a2, voffA);
            PG8_WAIT_V(8); PG8_WAIT_L(0); PG8_BAR; PG8_MMA(1, 0, At, B0); PG8_MMA(1, 1, At, B1); PG8_BAR; PG8_SCHED;
            PG8_LDB(B0, 1, 0); PG8_LDB(B1, 1, 1); PG8_SCHED; PG8_LDA(At, 1, 0); PG8_STAGE(PG8_SA(0, 1), a2 + hsA, voffA);
            PG8_WAIT_V(8); PG8_WAIT_L(0); PG8_BAR; PG8_MMA(0, 0, At, B0); PG8_MMA(0, 1, At, B1); PG8_BAR; PG8_SCHED;
            PG8_LDA(At, 1, 1); PG8_STAGE(PG8_SB(1, 0), b3, voffB); PG8_STAGE(PG8_SB(1, 1), b3 + hsB, voffB); PG8_STAGE(PG8_SA(1, 0), a3, voffA);
            PG8_WAIT_V(8); PG8_WAIT_L(0); PG8_BAR; PG8_MMA(1, 0, At, B0); PG8_MMA(1, 1, At, B1); PG8_BAR; PG8_SCHED;
            } else {
            PG8_LDB(B0, 0, 0); PG8_SCHED; PG8_LDA(At, 0, 0); PG8_STAGE(PG8_SA(1, 1), a1 + hsA, voffA);
            PG8_WAIT_L(8); PG8_BAR; PG8_WAIT_L(0); PG8_MMA(0, 0, At, B0); PG8_BAR; PG8_SCHED;
            PG8_LDB(B1, 0, 1); PG8_STAGE(PG8_SB(0, 0), b2, voffB);
            PG8_BAR; PG8_WAIT_L(0); PG8_MMA(0, 1, At, B1); PG8_BAR;
            PG8_LDA(At, 0, 1); PG8_STAGE(PG8_SA(0, 0), a2, voffA);
            PG8_BAR; PG8_WAIT_L(0); PG8_MMA(1, 0, At, B0); PG8_BAR; PG8_SCHED;
            PG8_STAGE(PG8_SB(0, 1), b2 + hsB, voffB);
            PG8_WAIT_V(6); PG8_BAR; PG8_MMA(1, 1, At, B1); PG8_BAR;
            PG8_LDB(B0, 1, 0); PG8_SCHED; PG8_LDA(At, 1, 0); PG8_STAGE(PG8_SA(0, 1), a2 + hsA, voffA);
            PG8_WAIT_L(8); PG8_BAR; PG8_WAIT_L(0); PG8_MMA(0, 0, At, B0); PG8_BAR; PG8_SCHED;
            PG8_LDB(B1, 1, 1); PG8_STAGE(PG8_SB(1, 0), b3, voffB);
            PG8_BAR; PG8_WAIT_L(0); PG8_MMA(0, 1, At, B1); PG8_BAR;
            PG8_LDA(At, 1, 1); PG8_STAGE(PG8_SA(1, 0), a3, voffA);
            PG8_BAR; PG8_WAIT_L(0); PG8_MMA(1, 0, At, B0); PG8_BAR; PG8_SCHED;
            PG8_STAGE(PG8_SB(1, 1), b3 + hsB, voffB);
            PG8_WAIT_V(6); PG8_BAR; PG8_MMA(1, 1, At, B1); PG8_BAR;
            }
        }
        if constexpr (ALIGN_EPI) { if (wr == 0) PG8_BAR; }
        if constexpr (!Epi::AFTER_DRAIN) { E(acc, cur, wr, wc, fr, fq); S.done(cur); }
        if (!has_next) break;
#pragma unroll
        for (int a = 0; a < 2; ++a)
#pragma unroll
            for (int b = 0; b < 2; ++b)
#pragma unroll
                for (int m = 0; m < 4; ++m)
#pragma unroll
                    for (int n = 0; n < 2; ++n) acc[a][b][m][n] = (f32x4){0.f, 0.f, 0.f, 0.f};
        cur = nxt; cA = nA; cB = nB; ++ui;
        if constexpr (ALIGN_EPI) { if (wr == 1) PG8_BAR; }
    }
    PG8_WAIT_V(0);
    if constexpr (!ALIGN_EPI) { if (wr == 0) PG8_BAR; }
    PG8_BAR;
    if constexpr (Epi::AFTER_DRAIN) { E.fused(acc, cur, wr, wc, fr, fq, lds, wid, lane); S.done(cur); }
#undef PG8_APTR
#undef PG8_SA
#undef PG8_SB
#undef PG8_STAGE
#undef PG8_LDA
#undef PG8_LDB
#undef PG8_MMA
#undef PG8_WAIT_V
#undef PG8_WAIT_L
#undef PG8_BAR
#undef PG8_SCHED
}
}

constexpr int NWAVES = 8, NTHR = NWAVES * 64;
constexpr int DM = 2048, NB = 4, SEQ = 2048, MROWS = NB * SEQ;
constexpr int WP = 1024, WL = 1024, NZ = 4096;
constexpr int CHUNK = 128, NCHUNK = SEQ / CHUNK;
constexpr float EPS = 1e-6f;
constexpr int KC_MOD = 8;

constexpr size_t MiB = 1u << 20;
constexpr size_t WS_MODP = 1 * MiB;
constexpr size_t WS_GATE = 2 * MiB;
constexpr size_t WS_SLOT = 3 * MiB;
constexpr size_t WS_SP8 = 2 * MiB + 512 * 1024;
constexpr size_t WS_AGG = 4 * MiB;
constexpr size_t WS_WIN = 8 * MiB;
constexpr size_t WS_WOUT = 24 * MiB;
constexpr size_t WS_WGATE = 32 * MiB;
constexpr size_t WS_WPOOL = 34 * MiB;
constexpr size_t WS_H = 36 * MiB;
constexpr size_t WS_Z = 68 * MiB;
constexpr size_t WS_UC = 132 * MiB;
constexpr size_t WS_POOLED = 148 * MiB;
constexpr size_t WS_GT = 164 * MiB;
constexpr size_t WS_YP = 228 * MiB;
constexpr size_t WS_END = 244 * MiB;
constexpr size_t WS_HLF = WS_H, WS_HLB = WS_H + 16 * MiB, WS_PF = WS_GT + 32 * MiB, WS_PB = WS_WIN, WS_A2 = WS_GT;

constexpr int LDS_BYTES = 147456;

#define LAS __attribute__((address_space(3)))
typedef unsigned short bf16;
typedef float f32x4 __attribute__((ext_vector_type(4)));
typedef unsigned u32x4 __attribute__((ext_vector_type(4)));
typedef unsigned u32x2 __attribute__((ext_vector_type(2)));

__device__ __forceinline__ unsigned f2bf(float f) { unsigned u = __builtin_bit_cast(unsigned, f); return (u + 0x7fffu + ((u >> 16) & 1u)) >> 16; }
__device__ __forceinline__ unsigned pk2(float lo, float hi) { return pg8::cvt_pk_bf16(lo, hi); }
__device__ __forceinline__ float bflo(unsigned w) { return __builtin_bit_cast(float, w << 16); }
__device__ __forceinline__ float bfhi(unsigned w) { return __builtin_bit_cast(float, w & 0xffff0000u); }
__device__ __forceinline__ float bf1(bf16 h) { return __builtin_bit_cast(float, (unsigned)h << 16); }
__device__ __forceinline__ void unpack8(const u32x4 w, float (&f)[8]) { f[0] = bflo(w.x); f[1] = bfhi(w.x); f[2] = bflo(w.y); f[3] = bfhi(w.y); f[4] = bflo(w.z); f[5] = bfhi(w.z); f[6] = bflo(w.w); f[7] = bfhi(w.w); }
__device__ __forceinline__ u32x4 pack8(const float (&f)[8]) { u32x4 w; w.x = pk2(f[0], f[1]); w.y = pk2(f[2], f[3]); w.z = pk2(f[4], f[5]); w.w = pk2(f[6], f[7]); return w; }
__device__ __forceinline__ float wave_sum(float v) {
#pragma unroll
    for (int o = 1; o < 64; o <<= 1) v += __shfl_xor(v, o);
    return v;
}
__device__ __forceinline__ float sigmoidf_(float x) { return pg8::fsigmoid(x); }
__device__ __forceinline__ float siluf_(float x) { return x * pg8::fsigmoid(x); }

#define XB_TMO      128
#define XB_XCNT(j)  (256  + 64 * (j))
#define XB_XSUB(j)  (1280 + 64 * (j))
#define XB_XGEN(j)  (2304 + 64 * (j))
#define XB_TOP      3328
#define XB_TOPGEN   3392
#define XCD_BAR_WORDS 3456
#define XB_SPIN_CAP (1u << 18)
__device__ __forceinline__ unsigned xb_ld(unsigned* p)              { return __hip_atomic_load(p, __ATOMIC_RELAXED, __HIP_MEMORY_SCOPE_AGENT); }
__device__ __forceinline__ unsigned xb_add(unsigned* p, unsigned v) { return __hip_atomic_fetch_add(p, v, __ATOMIC_RELAXED, __HIP_MEMORY_SCOPE_AGENT); }
__device__ __forceinline__ unsigned xb_xcc_id() { return (unsigned)__builtin_amdgcn_s_getreg((3 << 11) | 20) & 0xFu; }
#define XB_SPIN(cond, bar) do { unsigned _sp = 0; while (cond) { __builtin_amdgcn_s_sleep(1); \
    if ((++_sp & 255u) == 0u) { if (xb_ld(&(bar)[XB_TMO])) break; if (_sp > XB_SPIN_CAP) { atomicAdd(&(bar)[XB_TMO], 1u); break; } } } } while (0)
struct XcdBarrier { unsigned* bar; unsigned x; volatile LAS unsigned* st; };
__device__ __forceinline__ XcdBarrier xcd_barrier_post(unsigned* bar, volatile LAS unsigned* st) {
    XcdBarrier b; b.bar = bar; b.x = xb_xcc_id(); b.st = st;
    if (threadIdx.x == 0) (void)xb_add(&bar[XB_XCNT(b.x)], 1u);
    return b;
}
__device__ __forceinline__ void xcd_barrier_complete(unsigned* bar, unsigned x, unsigned& nloc, unsigned& nx) {
    const unsigned G = gridDim.x * gridDim.y * gridDim.z;
    unsigned sum, cnt, mine, sp = 0u;
    for (;;) {
        sum = 0u; cnt = 0u; mine = 0u;
#pragma unroll
        for (unsigned j = 0; j < 16; ++j) { const unsigned c = xb_ld(&bar[XB_XCNT(j)]); sum += c; cnt += (c > 0u) ? 1u : 0u; mine = (j == x) ? c : mine; }
        if (sum == G) break;
        __builtin_amdgcn_s_sleep(1);
        if ((++sp & 255u) == 0u) { if (xb_ld(&bar[XB_TMO])) break; if (sp > XB_SPIN_CAP) { atomicAdd(&bar[XB_TMO], 1u); break; } }
    }
    nloc = mine > 0u ? mine : 1u; nx = cnt > 0u ? cnt : 1u;
}
__device__ __forceinline__ void xcd_barrier(const XcdBarrier& b) {
    asm volatile("s_waitcnt vmcnt(0)" ::: "memory");
    __syncthreads();
    if (threadIdx.x == 0) {
        unsigned* bar = b.bar;
        __builtin_amdgcn_s_waitcnt(0);
        unsigned nloc = b.st[0], nx = b.st[1];
        if (nloc == 0u) { xcd_barrier_complete(bar, b.x, nloc, nx); b.st[0] = nloc; b.st[1] = nx; }
        const unsigned old = xb_add(&bar[XB_XSUB(b.x)], 1u);
        const unsigned gen = old / nloc;
        if (old + 1u == (gen + 1u) * nloc) {
            __builtin_amdgcn_fence(__ATOMIC_RELEASE, "agent");
            asm volatile("s_waitcnt vmcnt(0)" ::: "memory");
            const unsigned og = xb_add(&bar[XB_TOP], 1u);
            const unsigned tg = og / nx;
            if (og + 1u == (tg + 1u) * nx) xb_add(&bar[XB_TOPGEN], 1u);
            else XB_SPIN(xb_ld(&bar[XB_TOPGEN]) == tg, bar);
            __builtin_amdgcn_fence(__ATOMIC_ACQUIRE, "agent");
            xb_add(&bar[XB_XGEN(b.x)], 1u);
            asm volatile("s_waitcnt vmcnt(0)" ::: "memory");
        } else {
            XB_SPIN(xb_ld(&bar[XB_XGEN(b.x)]) == gen, bar);
            __builtin_amdgcn_fence(__ATOMIC_ACQUIRE, "agent");
            asm volatile("s_waitcnt vmcnt(0)" ::: "memory");
        }
    }
    __syncthreads();
}

struct Args {
    const float* in[20]; float* out; unsigned char* ws; int ph_lo, ph_hi;
};

__device__ __forceinline__ void p0_transpose_item(const float* W, int K, int N, bf16* WT, int row_off, LAS float* scr, int item, int lane, bool gmap = false, float wscale = 1.f, bool pmap = false) {
    const int nblk = N / 32, kb = item / nblk, nb = item % nblk, k0 = 64 * kb, n0 = 32 * nb;
    float tv[32];
#pragma unroll
    for (int i = 0; i < 32; ++i) { const int kk = 2 * i + (lane >> 5); tv[i] = __builtin_nontemporal_load(W + (size_t)(k0 + kk) * N + n0 + (lane & 31)); }
#pragma unroll
    for (int i = 0; i < 32; ++i) { const int kk = 2 * i + (lane >> 5); scr[kk * 33 + (lane & 31)] = tv[i]; }
    asm volatile("s_waitcnt lgkmcnt(0)" ::: "memory");
    const int c = lane & 7;
#pragma unroll
    for (int j = 0; j < 4; ++j) { const int n = (lane >> 3) + 8 * j; const LAS float* s = scr + (8 * c) * 33 + n;
        u32x4 o; o.x = pk2(s[0 * 33] * wscale, s[1 * 33] * wscale); o.y = pk2(s[2 * 33] * wscale, s[3 * 33] * wscale); o.z = pk2(s[4 * 33] * wscale, s[5 * 33] * wscale); o.w = pk2(s[6 * 33] * wscale, s[7 * 33] * wscale);
        if (gmap) {
            const int e = n0 + n, g = e >> 8, ch = e & 255, k8 = k0 + 8 * c;
            *(u32x4*)(WT + (size_t)row_off * K + (size_t)((((g * 8 + (ch >> 5)) * 16 + (k8 >> 4)) * 64 + (ch & 31) + 32 * ((k8 >> 3) & 1)) * 8)) = o;
        } else if (pmap) {
            const int e = n0 + n, k8 = k0 + 8 * c;
            *(u32x4*)(WT + (size_t)row_off * K + (size_t)((((e >> 5) * 16 + (k8 >> 4)) * 64 + (e & 31) + 32 * ((k8 >> 3) & 1)) * 8)) = o;
        } else *(u32x4*)(WT + (size_t)(row_off + n0 + n) * K + k0 + 8 * c) = o; }
    asm volatile("s_waitcnt lgkmcnt(0)" ::: "memory");
}

template <int W> __device__ __forceinline__ void pool_slide_item(const bf16* Z, bf16* POOLED, int gI, int tokoct, int v) {
    constexpr int LO = W / 2, HI = W - LO - 1, NR = W + 7;
    const int c0 = gI * 256 + v * 8, row0 = tokoct * 8, t0 = row0 & (SEQ - 1);
    const bf16* zp = Z + (size_t)(row0 - t0) * NZ + c0;
    u32x4 raw[NR];
#pragma unroll
    for (int k = 0; k < NR; ++k) { int tt = t0 - LO + k; tt = tt < 0 ? 0 : (tt > SEQ - 1 ? SEQ - 1 : tt); raw[k] = *(const u32x4*)(zp + (size_t)tt * NZ); }
    float S[8] = {0.f, 0.f, 0.f, 0.f, 0.f, 0.f, 0.f, 0.f}, f[8];
#pragma unroll
    for (int k = 0; k < W; ++k) { const int tt = t0 - LO + k; const float wgt = (tt >= 0 && tt < SEQ) ? 1.f : 0.f; unpack8(raw[k], f);
#pragma unroll
        for (int e = 0; e < 8; ++e) S[e] += wgt * f[e]; }
#pragma unroll
    for (int j = 0; j < 8; ++j) {
        const int t = t0 + j, st = (t - LO) < 0 ? 0 : (t - LO), en = ((t + HI) > (SEQ - 1) ? (SEQ - 1) : (t + HI)) + 1;
        const float inv = __builtin_amdgcn_rcpf((float)(en - st));
        float o[8]; unpack8(raw[j + LO], f);
#pragma unroll
        for (int e = 0; e < 8; ++e) o[e] = S[e] * inv - f[e];
        *(u32x4*)(POOLED + (size_t)(row0 + j) * WP + c0) = pack8(o);
        if (j < 7) {
            { const int tt = t0 - LO + j + W; const float wgt = (tt >= 0 && tt < SEQ) ? 1.f : 0.f; unpack8(raw[j + W], f);
#pragma unroll
              for (int e = 0; e < 8; ++e) S[e] += wgt * f[e]; }
            { const int tt = t0 - LO + j; const float wgt = (tt >= 0 && tt < SEQ) ? 1.f : 0.f; unpack8(raw[j], f);
#pragma unroll
              for (int e = 0; e < 8; ++e) S[e] -= wgt * f[e]; }
        }
    }
}

typedef float f32x16 __attribute__((ext_vector_type(16)));
typedef short bf16x8v __attribute__((ext_vector_type(8)));
template <int DIR> __device__ __forceinline__ void gate_dir(LAS unsigned char* lds, const bf16* WGT, const float* bgate, const float* sp8t, bf16* HL, bf16* PP, float* AGG,
                                                             int tid, int lane, int wv, int hd, int row0, int b, int chunk) {
    const int r = lane & 31, h = lane >> 5, c = 32 * wv + r, mi = DIR * 4 + hd;
    bf16x8v Bf[2][16];
#pragma unroll
    for (int g = 0; g < 2; ++g) { const bf16* wfr = WGT + (size_t)mi * 512 * 256 + (size_t)((g * 8 + wv) * 16) * 512 + lane * 8;
#pragma unroll
        for (int ks = 0; ks < 16; ++ks) Bf[g][ks] = *(const bf16x8v*)(wfr + ks * 512); }
    const float brs = bgate[mi * 512 + c] * -1.44269504f, bis = bgate[mi * 512 + 256 + c] * -1.44269504f, sp = sp8t[DIR * WL + hd * 256 + c];
    float Pc = 1.f, Hc = 0.f;
#pragma unroll 1
    for (int mi2 = 0; mi2 < 4; ++mi2) {
        int zi; asm volatile("v_mov_b32 %0, 0" : "=v"(zi));
        const int mt = DIR ? 3 - mi2 : mi2, arow = 32 * mt + r;
        f32x16 ar, ai;
#pragma unroll
        for (int q = 0; q < 16; ++q) { ar[q] = 0.f; ai[q] = 0.f; }
        LAS const unsigned char* abase = lds + arow * 528 + h * 16;
        const int hz = h + zi;
        bf16x8v Afc = *(LAS const bf16x8v*)(abase);
#pragma unroll
        for (int ks = 0; ks < 16; ++ks) { bf16x8v Afn = Afc;
            if (ks < 15) Afn = *(LAS const bf16x8v*)(abase + (ks + 1) * 32);
            ar = __builtin_amdgcn_mfma_f32_32x32x16_bf16(Afc, Bf[0][ks], ar, 0, 0, 0); ai = __builtin_amdgcn_mfma_f32_32x32x16_bf16(Afc, Bf[1][ks], ai, 0, 0, 0);
            Afc = Afn; }
        unsigned short ub[16];
        { LAS const unsigned char* ubase = lds + (32 * mt + 4 * hz) * 528 + c * 2;
#pragma unroll
          for (int q = 0; q < 16; ++q) ub[q] = *(LAS const unsigned short*)(ubase + ((q & 3) + 8 * (q >> 2)) * 528); }
        float av[16], bxv[16];
#pragma unroll
        for (int q = 0; q < 16; ++q) { const float u = bf1(ub[q]);
            const float dr = 1.f + __builtin_amdgcn_exp2f(fminf(ar[q] + brs, 60.f)), di = 1.f + __builtin_amdgcn_exp2f(fminf(ai[q] + bis, 60.f));
            const float inv = __builtin_amdgcn_rcpf(dr * di), rr = inv * di, ig = inv * dr;
            const float a = __builtin_amdgcn_exp2f(rr * sp), m2 = __builtin_fmaf(-a, a, 1.f);
            av[q] = a; bxv[q] = __builtin_amdgcn_sqrtf(m2) * ig * u; }
        float Pg[4], Hg[4], Pp[4], Hp[4], cinH[4], cinP[4];
#pragma unroll
        for (int g = 0; g < 4; ++g) { float P = 1.f, H = 0.f;
#pragma unroll
            for (int jj = 0; jj < 4; ++jj) { const int q = 4 * g + (DIR ? 3 - jj : jj); H = av[q] * H + bxv[q]; P *= av[q]; bxv[q] = H; av[q] = P; }
            Pg[g] = P; Hg[g] = H; Pp[g] = __shfl_xor(P, 32); Hp[g] = __shfl_xor(H, 32); }
#pragma unroll
        for (int gg = 0; gg < 4; ++gg) { const int g = DIR ? 3 - gg : gg;
            const float P0 = h ? Pp[g] : Pg[g], H0 = h ? Hp[g] : Hg[g], P1 = h ? Pg[g] : Pp[g], H1 = h ? Hg[g] : Hp[g];
            if (DIR == 0) { const float Hca = H0 + P0 * Hc, Pca = Pc * P0; cinH[g] = h ? Hca : Hc; cinP[g] = h ? Pca : Pc; Hc = H1 + P1 * Hca; Pc = Pca * P1; }
            else          { const float Hca = H1 + P1 * Hc, Pca = Pc * P1; cinH[g] = h ? Hc : Hca; cinP[g] = h ? Pc : Pca; Hc = H0 + P0 * Hca; Pc = Pca * P0; } }
        { unsigned short* hb = (unsigned short*)HL + (size_t)(row0 + 32 * mt) * WL + hd * 256; unsigned short* pb = (unsigned short*)PP + (size_t)(row0 + 32 * mt) * WL + hd * 256;
          const int loff = 4 * hz * WL + c;
          int zo; asm volatile("v_mov_b32 %0, 0" : "=v"(zo) : "v"(cinH[0]));
          LAS unsigned short* park = (LAS unsigned short*)(lds + 69632) + ((wv * 4 + mt) * 16) * 64 + lane + zo;
#pragma unroll
          for (int q = 0; q < 16; ++q) { const int tl = (q & 3) + 8 * (q >> 2); float ho = bxv[q] + av[q] * cinH[q >> 2]; const float po = av[q] * cinP[q >> 2];
              if (DIR == 1) ho += bf1(park[q * 64]);
              const unsigned w = pg8::cvt_pk_bf16(ho, po);
              if (DIR == 0) park[q * 64] = (unsigned short)(w & 0xffffu); else (hb + tl * WL)[loff] = (unsigned short)(w & 0xffffu);
              (pb + tl * WL)[loff] = (unsigned short)(w >> 16); } }
    }
    if (h == 0) { float* ag = AGG + (size_t)(((b * NCHUNK + chunk) * 2 + DIR) * 2) * WL + hd * 256 + c; ag[0] = Pc; ag[WL] = Hc; }
}
__device__ __forceinline__ void gate_item(LAS unsigned char* lds, const bf16* Zu, const float* conv_w, const float* conv_b, const bf16* WGT, const float* bgate, const float* sp8t, bf16* HLF, bf16* HLB, bf16* PF, bf16* PB, float* AGG, int it) {
    int z; asm volatile("v_mov_b32 %0, 0" : "=v"(z));
    const int tid = (int)threadIdx.x + z, lane = tid & 63, wv = __builtin_amdgcn_readfirstlane(tid >> 6);
    const int tile = it >> 2, hd = it & 3, row0 = tile * 128, b = row0 / SEQ, chunk = (row0 % SEQ) / CHUNK;
    __syncthreads();
    {
        const int t0 = row0 % SEQ;
#pragma unroll 2
        for (int i = 0; i < 8; ++i) { const int id = tid + NTHR * i, row = id >> 5, kc = id & 31, t = t0 + row, c0 = hd * 256 + kc * 8;
            const bf16* zp = Zu + (size_t)(row0 - t0) * NZ + c0;
            u32x4 raw[4];
#pragma unroll
            for (int k = 0; k < 4; ++k) { int tt = t + k - 2; tt = tt < 0 ? 0 : (tt > SEQ - 1 ? SEQ - 1 : tt); raw[k] = *(const u32x4*)(zp + (size_t)tt * NZ); }
            float a8[8], f[8];
            { const f32x4 b0 = *(const f32x4*)(conv_b + c0), b1 = *(const f32x4*)(conv_b + c0 + 4); a8[0] = b0.x; a8[1] = b0.y; a8[2] = b0.z; a8[3] = b0.w; a8[4] = b1.x; a8[5] = b1.y; a8[6] = b1.z; a8[7] = b1.w; }
#pragma unroll
            for (int k = 0; k < 4; ++k) { const int tt = t + k - 2; const float wgt = (tt >= 0 && tt < SEQ) ? 1.f : 0.f; unpack8(raw[k], f);
                const f32x4 w0 = *(const f32x4*)(conv_w + k * WL + c0) * wgt, w1 = *(const f32x4*)(conv_w + k * WL + c0 + 4) * wgt;
                a8[0] += w0.x * f[0]; a8[1] += w0.y * f[1]; a8[2] += w0.z * f[2]; a8[3] += w0.w * f[3]; a8[4] += w1.x * f[4]; a8[5] += w1.y * f[5]; a8[6] += w1.z * f[6]; a8[7] += w1.w * f[7]; }
            *(LAS u32x4*)(lds + row * 528 + (kc << 4)) = pack8(a8); }
    }
    __syncthreads();
    gate_dir<0>(lds, WGT, bgate, sp8t, HLF, PF, AGG, tid, lane, wv, hd, row0, b, chunk);
    gate_dir<1>(lds, WGT, bgate, sp8t, HLF, PB, AGG, tid, lane, wv, hd, row0, b, chunk);
}

template <int W> __device__ __forceinline__ void pooled_tile_to_lds(const bf16* Zg, LAS unsigned char* lds, int row0, int t0, int tid) {
    constexpr int LO = W / 2, HI = W - LO - 1, TOK = 4, NR = W + TOK - 1;
#pragma unroll 1
    for (int itx = 0; itx < 2; ++itx) {
        const int id = tid + NTHR * itx, tloc0 = (id >> 5) * TOK, v = id & 31, t = t0 + tloc0;
        const bf16* zp = Zg + (size_t)(row0 - t0) * NZ + v * 8;
        u32x4 raw[NR];
#pragma unroll
        for (int k = 0; k < NR; ++k) { int tt = t - LO + k; tt = tt < 0 ? 0 : (tt > SEQ - 1 ? SEQ - 1 : tt); raw[k] = *(const u32x4*)(zp + (size_t)tt * NZ); }
        float S[8] = {0.f, 0.f, 0.f, 0.f, 0.f, 0.f, 0.f, 0.f}, f[8];
#pragma unroll
        for (int k = 0; k < W; ++k) { const int tt = t - LO + k; const float wgt = (tt >= 0 && tt < SEQ) ? 1.f : 0.f; unpack8(raw[k], f);
#pragma unroll
            for (int e = 0; e < 8; ++e) S[e] += wgt * f[e]; }
#pragma unroll
        for (int j = 0; j < TOK; ++j) {
            const int tj = t + j, st = (tj - LO) < 0 ? 0 : (tj - LO), en = ((tj + HI) > (SEQ - 1) ? (SEQ - 1) : (tj + HI)) + 1;
            const float inv = __builtin_amdgcn_rcpf((float)(en - st));
            float o[8]; unpack8(raw[j + LO], f);
#pragma unroll
            for (int e = 0; e < 8; ++e) o[e] = S[e] * inv - f[e];
            *(LAS u32x4*)(lds + (tloc0 + j) * 528 + (v << 4)) = pack8(o);
            if (j < TOK - 1) {
                { const int tt = t - LO + j + W; const float wgt = (tt >= 0 && tt < SEQ) ? 1.f : 0.f; unpack8(raw[j + W], f);
#pragma unroll
                  for (int e = 0; e < 8; ++e) S[e] += wgt * f[e]; }
                { const int tt = t - LO + j; const float wgt = (tt >= 0 && tt < SEQ) ? 1.f : 0.f; unpack8(raw[j], f);
#pragma unroll
                  for (int e = 0; e < 8; ++e) S[e] -= wgt * f[e]; }
            }
        }
    }
}
__device__ __forceinline__ void pool_item(LAS unsigned char* lds, const bf16* Z, const bf16* WPF, const float* b_pool, const float* pool_scale, bf16* YP, int it) {
    int z; asm volatile("v_mov_b32 %0, 0" : "=v"(z));
    const int tid = (int)threadIdx.x + z, lane = tid & 63, wv = __builtin_amdgcn_readfirstlane(tid >> 6), r = lane & 31, h = lane >> 5, c = 32 * wv + r;
    const int tile = it >> 2, g = it & 3, row0 = tile * 128, t0 = row0 % SEQ;
    __syncthreads();
    if (g == 0) pooled_tile_to_lds<2>(Z, lds, row0, t0, tid);
    else if (g == 1) pooled_tile_to_lds<4>(Z + 256, lds, row0, t0, tid);
    else if (g == 2) pooled_tile_to_lds<8>(Z + 512, lds, row0, t0, tid);
    else pooled_tile_to_lds<16>(Z + 768, lds, row0, t0, tid);
    bf16x8v Bf[16];
    { int zb; asm volatile("v_mov_b32 %0, 0" : "=v"(zb));
      const bf16* wfr = WPF + (size_t)g * 65536 + (size_t)(wv * 16) * 512 + (lane + zb) * 8;
#pragma unroll
      for (int ks = 0; ks < 16; ++ks) Bf[ks] = *(const bf16x8v*)(wfr + ks * 512); }
    const float bq = b_pool[g * 256 + c], sq = pool_scale[g * 256 + c];
    __syncthreads();
    unsigned short* yb = (unsigned short*)YP + (size_t)row0 * WP + g * 256;
    const int loff = 4 * h * WP + c;
#pragma unroll 1
    for (int mt = 0; mt < 4; ++mt) {
        f32x16 acc;
#pragma unroll
        for (int q = 0; q < 16; ++q) acc[q] = 0.f;
        LAS const unsigned char* abase = lds + (32 * mt + r) * 528 + h * 16;
#pragma unroll
        for (int ks = 0; ks < 16; ++ks) acc = __builtin_amdgcn_mfma_f32_32x32x16_bf16(*(LAS const bf16x8v*)(abase + ks * 32), Bf[ks], acc, 0, 0, 0);
#pragma unroll
        for (int q = 0; q < 16; q += 2) { const int tl = (q & 3) + 8 * (q >> 2);
            const unsigned w = pg8::cvt_pk_bf16((acc[q] + bq) * sq, (acc[q + 1] + bq) * sq);
            (yb + (size_t)(32 * mt + tl) * WP)[loff] = (unsigned short)(w & 0xffffu); (yb + (size_t)(32 * mt + tl + 1) * WP)[loff] = (unsigned short)(w >> 16); }
    }
}

__global__ void __launch_bounds__(NTHR, 2) fwd_kernel(Args args) {
    extern __shared__ __attribute__((aligned(16))) unsigned char lds_raw[];
    LAS unsigned char* lds = (LAS unsigned char*)lds_raw;
    cg::grid_group grid = cg::this_grid();
    const int tid0 = threadIdx.x, wave = __builtin_amdgcn_readfirstlane(tid0 >> 6);
#define PH_IDS int _z; asm volatile("v_mov_b32 %0, 0" : "=v"(_z)); const int tid = (int)threadIdx.x + _z, lane = tid & 63; (void)lane; (void)tid;
    const int G = gridDim.x, blk = blockIdx.x;
    const int gw = blk * NWAVES + wave, NGW = G * NWAVES;
    unsigned char* ws = args.ws;
    const float* x = args.in[0]; const float* cvec = args.in[1]; const float* norm_g = args.in[2]; const float* w_ada = args.in[3]; const float* b_ada = args.in[4];
    const float* w_in = args.in[5]; const float* b_in = args.in[6]; const float* w_pool = args.in[7]; const float* b_pool = args.in[8]; const float* pool_scale = args.in[9];
    const float* conv_w = args.in[10]; const float* conv_b = args.in[11]; const float* w_gate = args.in[12]; const float* b_gate = args.in[13]; const float* lru_lambda = args.in[14];
    const float* onp_g = args.in[15]; const float* onl_g = args.in[16]; const float* w_out = args.in[17]; const float* b_out = args.in[18]; const float* fin_g = args.in[19];
    float* out = args.out;
    float* MODP = (float*)(ws + WS_MODP); float* GATE = (float*)(ws + WS_GATE); float* AGG = (float*)(ws + WS_AGG);
    bf16* WIN_T = (bf16*)(ws + WS_WIN); bf16* WOUT_T = (bf16*)(ws + WS_WOUT); bf16* WGATE_T = (bf16*)(ws + WS_WGATE); bf16* WPOOL_T = (bf16*)(ws + WS_WPOOL);
    bf16* HB = (bf16*)(ws + WS_H); bf16* Z = (bf16*)(ws + WS_Z); bf16* UC = (bf16*)(ws + WS_UC); bf16* POOLED = (bf16*)(ws + WS_POOLED);
    bf16* GT = (bf16*)(ws + WS_GT); bf16* YP = (bf16*)(ws + WS_YP);
    bf16* HLF = (bf16*)(ws + WS_HLF); bf16* HLB = (bf16*)(ws + WS_HLB); bf16* PF = (bf16*)(ws + WS_PF); bf16* PB = (bf16*)(ws + WS_PB); bf16* A2 = (bf16*)(ws + WS_A2);

    const int lo = args.ph_lo, hi = args.ph_hi;
#define IN(k) (lo <= (k) && (k) < hi)
#define SEAM(k) do { if (IN(k) && IN((k) + 1)) xcd_barrier(bar); } while (0)
    volatile LAS unsigned* MISC = (volatile LAS unsigned*)(lds + LDS_BYTES - 256);
    if (tid0 < 32) MISC[tid0] = 0u;
    __syncthreads();
    XcdBarrier bar; bar.bar = (unsigned*)ws; bar.x = 0; bar.st = MISC;
    if (hi - lo > 1) bar = xcd_barrier_post((unsigned*)ws, MISC);
    if (lo > 1000) grid.sync();

    if (IN(0)) {
        PH_IDS
        if (blk < 24 * KC_MOD) {
            const int cc = blk % 24, kc = blk / 24, kb = kc * 256 + wave * 32, col = cc * 256 + lane * 4;
            float cs[NB];
#pragma unroll
            for (int b = 0; b < NB; ++b) cs[b] = siluf_(cvec[b * DM + kb + (lane & 31)]);
            f32x4 acc[NB];
#pragma unroll
            for (int b = 0; b < NB; ++b) acc[b] = (f32x4){0.f, 0.f, 0.f, 0.f};
            const float* wp = w_ada + (size_t)kb * (3 * DM) + col;
#pragma unroll 16
            for (int i = 0; i < 32; ++i) { const f32x4 wv = __builtin_nontemporal_load((const f32x4*)(wp + (size_t)i * (3 * DM)));
#pragma unroll
                for (int b = 0; b < NB; ++b) { const float s = __shfl(cs[b], i); acc[b] += wv * s; } }
            LAS float* red = (LAS float*)lds;
#pragma unroll
            for (int b = 0; b < NB; ++b) *(LAS f32x4*)(red + (wave * NB + b) * 256 + lane * 4) = acc[b];
            __syncthreads();
#pragma unroll
            for (int e = 0; e < 2; ++e) { const int o = tid * 2 + e, b = o >> 8, cl = o & 255; float s = 0.f;
#pragma unroll
                for (int w = 0; w < NWAVES; ++w) s += red[(w * NB + b) * 256 + cl];
                MODP[(size_t)(kc * NB + b) * (3 * DM) + cc * 256 + cl] = s; }
            __syncthreads();
        }
        LAS float* scr = (LAS float*)(lds + wave * 16384);
        constexpr int I_IN = (DM / 64) * (NZ / 32), I_G1 = (256 / 64) * (512 / 32), I_P1 = (256 / 64) * (256 / 32);
        constexpr int NITEMS = I_IN + 8 * I_G1 + 4 * I_P1;
        const int nmod = (G > 24 * KC_MOD) ? 24 * KC_MOD : G;
        const int nvb = nmod + (G - nmod) * 3;
        const int nv = (blk < nmod) ? 1 : 3, v0 = (blk < nmod) ? blk : nmod + (blk - nmod) * 3;
        for (int vi = 0; vi < nv; ++vi)
            for (int it = (v0 + vi) * NWAVES + wave; it < NITEMS; it += nvb * NWAVES) {
                int r = it;
                if (r < I_IN) { p0_transpose_item(w_in, DM, NZ, WIN_T, 0, scr, r, lane); continue; } r -= I_IN;
                if (r < 8 * I_G1) { const int mi = r / I_G1; p0_transpose_item(w_gate + (size_t)mi * 256 * 512, 256, 512, WGATE_T, mi * 512, scr, r % I_G1, lane, true, -1.44269504f); continue; } r -= 8 * I_G1;
                { const int mi = r / I_P1; p0_transpose_item(w_pool + (size_t)mi * 256 * 256, 256, 256, WPOOL_T, mi * 256, scr, r % I_P1, lane, false, 1.f, true); }
            }
    }
    SEAM(0);

    if (IN(1)) {
        PH_IDS
        if (blk == 0) for (int i = tid; i < 2 * WL; i += NTHR) ((float*)(ws + WS_SP8))[i] = (-8.f * 1.44269504f) * log1pf(__expf(-lru_lambda[i]));
        LAS float* cA = (LAS float*)lds; LAS float* cB = cA + DM;
        for (int rb = blk; rb < MROWS / 32; rb += G) {
            const int b = rb / (SEQ / 32);
            __syncthreads();
            { const int c0 = tid * 4; f32x4 sh = *(const f32x4*)(b_ada + c0), sc = *(const f32x4*)(b_ada + DM + c0);
#pragma unroll
              for (int kc = 0; kc < KC_MOD; ++kc) { sh += *(const f32x4*)(MODP + (size_t)(kc * NB + b) * (3 * DM) + c0); sc += *(const f32x4*)(MODP + (size_t)(kc * NB + b) * (3 * DM) + DM + c0); }
              const f32x4 ng = *(const f32x4*)(norm_g + c0);
              *(LAS f32x4*)(cA + c0) = ng * (sc + 1.f); *(LAS f32x4*)(cB + c0) = sh; }
            if (tid < 32) { const int idx = rb * 32 + tid, bb = idx / DM, cl = idx % DM; float s = b_ada[2 * DM + cl];
#pragma unroll
                for (int kc = 0; kc < KC_MOD; ++kc) s += MODP[(size_t)(kc * NB + bb) * (3 * DM) + 2 * DM + cl];
                GATE[idx] = s; }
            __syncthreads();
#pragma unroll 1
            for (int q = 0; q < 4; q += 2) {
                const int row = rb * 32 + wave * 4 + q;
                const f32x4* xr = (const f32x4*)(x + (size_t)row * DM) + lane;
                f32x4 v[2][8]; float s[2] = {0.f, 0.f};
#pragma unroll
                for (int r2 = 0; r2 < 2; ++r2)
#pragma unroll
                    for (int j = 0; j < 8; ++j) v[r2][j] = __builtin_nontemporal_load(xr + r2 * (DM / 4) + 64 * j);
#pragma unroll
                for (int r2 = 0; r2 < 2; ++r2) {
#pragma unroll
                    for (int j = 0; j < 8; ++j) s[r2] += (v[r2][j].x * v[r2][j].x + v[r2][j].y * v[r2][j].y) + (v[r2][j].z * v[r2][j].z + v[r2][j].w * v[r2][j].w);
                    const float rstd = rsqrtf(wave_sum(s[r2]) * (1.f / DM) + EPS);
                    u32x2* o8 = (u32x2*)(HB + (size_t)(row + r2) * DM) + lane;
#pragma unroll
                    for (int j = 0; j < 8; ++j) { const int c0 = (64 * j + lane) * 4; const f32x4 a = *(const LAS f32x4*)(cA + c0), bb = *(const LAS f32x4*)(cB + c0);
                        const f32x4 h = v[r2][j] * rstd * a + bb; u32x2 w; w.x = pk2(h.x, h.y); w.y = pk2(h.z, h.w); o8[64 * j] = w; }
                }
            }
        }
    }
    SEAM(1);

    if (IN(2)) {
        PH_IDS
        pg8::Gemm g{HB, WIN_T, MROWS, NZ, DM, DM, 0, 0}; pg8::StaticOrder S; S.init(MROWS, NZ, G, blk);
        pg8::EpiBf16 E{Z, NZ, b_in, nullptr};
        pg8::gemm_phase<pg8::EpiBf16, pg8::StaticOrder, true, true>(lds, g, S, E);
    }
    SEAM(2);


    if (IN(4)) {
        PH_IDS
        static_assert(CHUNK == 128, "the gate phase scans 128-token chunks");
        for (int it = blk; it < (MROWS / 128) * 4; it += G) gate_item(lds, Z + WP, conv_w, conv_b, WGATE_T, b_gate, (const float*)(ws + WS_SP8), HLF, HLB, PF, PB, AGG, it);
        __syncthreads();
        for (int it = blk; it < (MROWS / 128) * 4; it += G) pool_item(lds, Z, WPOOL_T, b_pool, pool_scale, YP, it);
        __syncthreads();
        {
            constexpr int I_OUT = (DM / 64) * (DM / 32);
            LAS float* scr = (LAS float*)(lds + wave * 16384);
            int z3; asm volatile("v_mov_b32 %0, 0" : "=v"(z3)); const int ln3 = ((int)threadIdx.x + z3) & 63;
            for (int it = blk * NWAVES + wave; it < I_OUT; it += G * NWAVES) p0_transpose_item(w_out, DM, DM, WOUT_T, 0, scr, it, ln3);
        }
    }
    SEAM(4);

    if (IN(5)) {
        PH_IDS
        LAS float* cHf = (LAS float*)lds; LAS float* cHb = cHf + WL;
        for (int rb = blk; rb < MROWS / 32; rb += G) {
            const int b = rb / (SEQ / 32), chunk = (rb % (SEQ / 32)) / (CHUNK / 32);
            __syncthreads();
#pragma unroll 1
            for (int dir = 0; dir < 2; ++dir) {
                float pv[2][NCHUNK], hv[2][NCHUNK];
                const float* agb = AGG + (size_t)(b * NCHUNK * 4 + dir * 2) * WL + tid;
#pragma unroll
                for (int qi = 0; qi < 2; ++qi)
#pragma unroll
                    for (int jj = 0; jj < NCHUNK; ++jj) { pv[qi][jj] = agb[(size_t)jj * 4 * WL + qi * NTHR]; hv[qi][jj] = agb[(size_t)jj * 4 * WL + WL + qi * NTHR]; }
#pragma unroll
                for (int qi = 0; qi < 2; ++qi) { float Hf = 0.f, Hb = 0.f;
#pragma unroll
                    for (int jj = 0; jj < NCHUNK; ++jj) Hf = (jj < chunk) ? (hv[qi][jj] + pv[qi][jj] * Hf) : Hf;
#pragma unroll
                    for (int jj = NCHUNK - 1; jj >= 0; --jj) Hb = (jj > chunk) ? (hv[qi][jj] + pv[qi][jj] * Hb) : Hb;
                    (dir ? cHb : cHf)[tid + qi * NTHR] = dir ? Hb : Hf; }
            }
            __syncthreads();
#pragma unroll 1
            for (int q = 0; q < 4; ++q) {
                const int row = rb * 32 + wave * 4 + q;
                { float y[2][8]; float ss = 0.f;
#pragma unroll
                  for (int j = 0; j < 2; ++j) { const int c0 = (j * 64 + lane) * 8; unpack8(*(const u32x4*)(YP + (size_t)row * WP + c0), y[j]);
#pragma unroll
                      for (int e = 0; e < 8; ++e) ss += y[j][e] * y[j][e]; }
                  const float rstd = rsqrtf(wave_sum(ss) * (1.f / WP) + EPS);
#pragma unroll
                  for (int j = 0; j < 2; ++j) { const int c0 = (j * 64 + lane) * 8; float gp[8], o[8]; unpack8(*(const u32x4*)(Z + (size_t)row * NZ + 2048 + c0), gp);
                      const f32x4 g0 = *(const f32x4*)(onp_g + c0), g1 = *(const f32x4*)(onp_g + c0 + 4); const float gg[8] = {g0.x, g0.y, g0.z, g0.w, g1.x, g1.y, g1.z, g1.w};
#pragma unroll
                      for (int e = 0; e < 8; ++e) o[e] = y[j][e] * rstd * gg[e] * siluf_(gp[e]);
                      *(u32x4*)(A2 + (size_t)row * DM + c0) = pack8(o); } }
                { float y[2][8]; float ss = 0.f;
#pragma unroll
                  for (int j = 0; j < 2; ++j) { const int c0 = (j * 64 + lane) * 8; float hf[8], hb[8], pf[8], pb[8];
                      unpack8(*(const u32x4*)(HLF + (size_t)row * WL + c0), hf);
#pragma unroll
                      for (int e = 0; e < 8; ++e) hb[e] = 0.f;
                      unpack8(*(const u32x4*)(PF + (size_t)row * WL + c0), pf); unpack8(*(const u32x4*)(PB + (size_t)row * WL + c0), pb);
#pragma unroll
                      for (int e = 0; e < 8; ++e) { const float v = hf[e] + hb[e] + pf[e] * cHf[c0 + e] + pb[e] * cHb[c0 + e]; y[j][e] = v; ss += v * v; } }
                  const float rstd = rsqrtf(wave_sum(ss) * (1.f / WL) + EPS);
#pragma unroll
                  for (int j = 0; j < 2; ++j) { const int c0 = (j * 64 + lane) * 8; float gp[8], o[8]; unpack8(*(const u32x4*)(Z + (size_t)row * NZ + 3072 + c0), gp);
                      const f32x4 g0 = *(const f32x4*)(onl_g + c0), g1 = *(const f32x4*)(onl_g + c0 + 4); const float gg[8] = {g0.x, g0.y, g0.z, g0.w, g1.x, g1.y, g1.z, g1.w};
#pragma unroll
                      for (int e = 0; e < 8; ++e) o[e] = y[j][e] * rstd * gg[e] * siluf_(gp[e]);
                      *(u32x4*)(A2 + (size_t)row * DM + WP + c0) = pack8(o); } }
            }
        }
    }
    SEAM(5);

    const bool fuse_norm = (G == (MROWS / 256) * (DM / 256));
    if (IN(6)) {
        PH_IDS
        pg8::Gemm g{A2, WOUT_T, MROWS, DM, DM, DM, 0, 0}; pg8::StaticOrder S; S.init(MROWS, DM, G, blk);
        if (fuse_norm) {
            pg8::EpiResidNorm E{out, x, GATE, b_out, fin_g, DM, SEQ, (float*)(ws + WS_SLOT), (unsigned*)ws + 4096, DM / 256, EPS, MROWS};
            pg8::gemm_phase<pg8::EpiResidNorm, pg8::StaticOrder, false, true>(lds, g, S, E);
        } else {
            pg8::EpiResid E{out, x, GATE, b_out, DM, SEQ};
            pg8::gemm_phase<pg8::EpiResid, pg8::StaticOrder, false, true>(lds, g, S, E);
        }
    }
    if (!fuse_norm) SEAM(6);

    if (IN(7) && !fuse_norm) {
        PH_IDS
        for (int row = gw; row < MROWS; row += NGW) {
            f32x4* xr = (f32x4*)(out + (size_t)row * DM) + lane;
            f32x4 v[8]; float s = 0.f;
#pragma unroll
            for (int j = 0; j < 8; ++j) { v[j] = xr[64 * j]; s += (v[j].x * v[j].x + v[j].y * v[j].y) + (v[j].z * v[j].z + v[j].w * v[j].w); }
            const float rstd = rsqrtf(wave_sum(s) * (1.f / DM) + EPS);
#pragma unroll
            for (int j = 0; j < 8; ++j) { const f32x4 gg = *((const f32x4*)fin_g + 64 * j + lane); xr[64 * j] = v[j] * rstd * gg; }
        }
    }
#undef IN
#undef SEAM
}

extern "C" void kernel_launch(void* const* d_in, const int* in_sizes, int n_in, void* d_out, int out_size, void* d_ws, size_t ws_size, hipStream_t stream) {
    static int grid = 0;
    if (grid == 0) {
        if (n_in != 20 || out_size != MROWS * DM || ws_size < WS_END) { fprintf(stderr, "kernel_launch: unexpected shapes (n_in %d out %d ws %zu)\n", n_in, out_size, ws_size); grid = -1; return; }
        int dev = 0, cus = 0, per_cu = 0;
        if (hipGetDevice(&dev) != hipSuccess || hipDeviceGetAttribute(&cus, hipDeviceAttributeMultiprocessorCount, dev) != hipSuccess) { grid = -1; return; }
        if (hipFuncSetAttribute((const void*)fwd_kernel, hipFuncAttributeMaxDynamicSharedMemorySize, LDS_BYTES) != hipSuccess) { fprintf(stderr, "kernel_launch: hipFuncSetAttribute failed\n"); grid = -1; return; }
        if (hipOccupancyMaxActiveBlocksPerMultiprocessor(&per_cu, (const void*)fwd_kernel, NTHR, LDS_BYTES) != hipSuccess || per_cu < 1) { fprintf(stderr, "kernel_launch: occupancy query says %d\n", per_cu); per_cu = 1; }
        (void)hipGetLastError();
        grid = cus * 1;
        fprintf(stderr, "kernel_launch: grid %d (cus %d, per_cu %d)\n", grid, cus, per_cu);
    }
    if (grid < 0) return;
    if (hipMemsetAsync(d_ws, 0, 65536, stream) != hipSuccess) { fprintf(stderr, "kernel_launch: memset failed\n"); return; }
    Args a{};
    for (int i = 0; i < 20; ++i) a.in[i] = (const float*)d_in[i];
    a.out = (float*)d_out; a.ws = (unsigned char*)d_ws;
    constexpr int NPH = 8;
#if MK_N_LAUNCHES == 1
    a.ph_lo = 0; a.ph_hi = NPH;
    void* kargs[] = {&a};
    hipError_t e = hipLaunchCooperativeKernel((const void*)fwd_kernel, dim3(grid), dim3(NTHR), kargs, LDS_BYTES, stream);
    if (e != hipSuccess) fprintf(stderr, "cooperative launch failed: %s (grid %d)\n", hipGetErrorString(e), grid);
#else
    for (int p = 0; p < NPH; ++p) {
        const int reps = ((PROBE_MASK >> p) & 1) ? 2 : 1;
        for (int r = 0; r < reps; ++r) {
            a.ph_lo = p; a.ph_hi = p + 1;
            void* kargs[] = {&a};
            hipError_t e = hipLaunchCooperativeKernel((const void*)fwd_kernel, dim3(grid), dim3(NTHR), kargs, LDS_BYTES, stream);
            if (e != hipSuccess) { fprintf(stderr, "launch %d failed: %s\n", p, hipGetErrorString(e)); break; }
        }
    }
#endif
}
```

```cpp
#include <hip/hip_runtime.h>
#include <hip/hip_cooperative_groups.h>
#include <cstdio>
#include <cstdint>
namespace cg = cooperative_groups;

#ifndef MK_N_LAUNCHES
#define MK_N_LAUNCHES 1
#endif
#ifndef PROBE_MASK
#define PROBE_MASK 256
#endif

namespace pg8 {
#define PG8_LAS __attribute__((address_space(3)))
typedef unsigned short bf16_t;
typedef short bf16x8 __attribute__((ext_vector_type(8)));
typedef float f32x4 __attribute__((ext_vector_type(4)));
typedef unsigned u32x4 __attribute__((ext_vector_type(4)));
typedef unsigned u32x2 __attribute__((ext_vector_type(2)));
constexpr int BM = 256, BK = 64, HALF = 128, HTB = HALF * BK * 2, STAGE_BYTES = 8 * HTB, NXCD = 8, WGM = 8;

__host__ __device__ __forceinline__ int lds_byte(int r, int c) { const int st = (r >> 4) * 2 + (c >> 5), rr = r & 15, cc = c & 31, ob = rr * 64 + cc * 2; return st * 1024 + (ob ^ (((ob >> 9) & 1) << 5)); }
__host__ __device__ __forceinline__ void stage_rc(int b, int& R, int& C) { const int st = b / 1024, sb = b % 1024, swz = sb ^ (((sb >> 9) & 1) << 5); R = (st >> 1) * 16 + swz / 64; C = (st & 1) * 32 + (swz % 64) / 2; }
__host__ __device__ __forceinline__ int perm32(int rho) { const int n = rho >> 4, i = rho & 15; return 8 * (i >> 2) + 4 * n + (i & 3); }

struct Unit { int pm, pn; };
struct Gemm { const bf16_t* A; const bf16_t* Bt; int M, N, K, lda, ashift, amask; };

struct StaticOrder {
    int nM, nN, nwg, G, c;
    __host__ __device__ void init(int M, int N, int G_, int c_) { nM = M / BM; nN = N / BM; nwg = nM * nN; G = G_; c = c_; }
    __host__ __device__ bool next(int i, Unit& u) const {
        const long L = (long)i * G + c; if (L >= nwg) return false;
        int wgid = (int)L; { const int q = nwg / NXCD, r = nwg % NXCD, xcd = wgid % NXCD, off = wgid / NXCD; wgid = (xcd < r ? xcd * (q + 1) : r * (q + 1) + (xcd - r) * q) + off; }
        const int nig = WGM * nN, gid = wgid / nig, fm = gid * WGM, gsz = (nM - fm) < WGM ? (nM - fm) : WGM;
        u.pm = fm + ((wgid % nig) % gsz); u.pn = (wgid % nig) / gsz; return true;
    }
    __device__ __forceinline__ void a_ready(const Unit&) const {}
    __device__ __forceinline__ void done(const Unit&) const {}
};

__device__ __forceinline__ unsigned cvt_pk_bf16(float lo, float hi) { unsigned r; asm volatile("v_cvt_pk_bf16_f32 %0, %1, %2" : "=v"(r) : "v"(lo), "v"(hi)); return r; }

struct EpiBf16 {
    static constexpr bool PERM = true, AFTER_DRAIN = false;
    bf16_t* O; int ldc; const float* bias; const float* scale;
    __device__ __forceinline__ void operator()(const f32x4 (&acc)[2][2][4][2], const Unit& u, int wr, int wc, int fr, int fq) const {
        const int row0 = u.pm * BM + wr * 64 + fr; const int col0 = u.pn * BM + wc * 32 + 8 * fq;
        f32x4 bv[2][2], sv[2][2];
#pragma unroll
        for (int bj = 0; bj < 2; ++bj)
#pragma unroll
            for (int n = 0; n < 2; ++n) { bv[bj][n] = *(const f32x4*)(bias + col0 + bj * HALF + 4 * n); sv[bj][n] = scale ? *(const f32x4*)(scale + col0 + bj * HALF + 4 * n) : (f32x4){1.f, 1.f, 1.f, 1.f}; }
#pragma unroll
        for (int ai = 0; ai < 2; ++ai)
#pragma unroll
            for (int m = 0; m < 4; ++m) { bf16_t* rowp = O + (size_t)(row0 + ai * HALF + m * 16) * ldc + col0;
#pragma unroll
                for (int bj = 0; bj < 2; ++bj) { f32x4 v0 = (acc[ai][bj][m][0] + bv[bj][0]) * sv[bj][0], v1 = (acc[ai][bj][m][1] + bv[bj][1]) * sv[bj][1];
                    u32x4 w; w.x = cvt_pk_bf16(v0[0], v0[1]); w.y = cvt_pk_bf16(v0[2], v0[3]); w.z = cvt_pk_bf16(v1[0], v1[1]); w.w = cvt_pk_bf16(v1[2], v1[3]);
                    *(u32x4*)(rowp + bj * HALF) = w; } }
    }
};
struct EpiResid {
    static constexpr bool PERM = false, AFTER_DRAIN = false;
    float* out; const float* x; const float* gate; const float* bias; int ldc; int rows_per_batch;
    __device__ __forceinline__ void operator()(const f32x4 (&acc)[2][2][4][2], const Unit& u, int wr, int wc, int fr, int fq) const {
        const int row0 = u.pm * BM + wr * 64 + fr, col0 = u.pn * BM + wc * 32 + 4 * fq;
        const float* gp = gate + (size_t)((u.pm * BM) / rows_per_batch) * ldc;
        f32x4 bv[2][2], gv[2][2];
#pragma unroll
        for (int bj = 0; bj < 2; ++bj)
#pragma unroll
            for (int n = 0; n < 2; ++n) { bv[bj][n] = *(const f32x4*)(bias + col0 + bj * HALF + n * 16); gv[bj][n] = *(const f32x4*)(gp + col0 + bj * HALF + n * 16); }
#pragma unroll
        for (int ai = 0; ai < 2; ++ai)
#pragma unroll
            for (int m = 0; m < 4; ++m) { const size_t ro = (size_t)(row0 + ai * HALF + m * 16) * ldc + col0;
#pragma unroll
                for (int bj = 0; bj < 2; ++bj)
#pragma unroll
                    for (int n = 0; n < 2; ++n) { const f32x4 xv = *(const f32x4*)(x + ro + bj * HALF + n * 16);
                        *(f32x4*)(out + ro + bj * HALF + n * 16) = xv + gv[bj][n] * (acc[ai][bj][m][n] + bv[bj][n]); } }
    }
};

struct EpiResidNorm {
    static constexpr bool PERM = false, AFTER_DRAIN = true;
    float* out; const float* x; const float* gate; const float* bias; const float* fg; int ldc; int rows_per_batch;
    float* slots;
    unsigned* cnt;
    int nN; float eps;
    __device__ __forceinline__ void operator()(const f32x4 (&)[2][2][4][2], const Unit&, int, int, int, int) const {}
    __device__ __forceinline__ void fused(f32x4 (&acc)[2][2][4][2], const Unit& u, int wr, int wc, int fr, int fq, PG8_LAS unsigned char* lds, int wid, int lane) const {
        constexpr int LPT = 260;
        const int tid = threadIdx.x;
        PG8_LAS float* T = (PG8_LAS float*)lds;
        const int colg = u.pn * BM + 4 * lane;
        const float* gp = gate + (size_t)((u.pm * BM) / rows_per_batch) * ldc;
        const f32x4 bvec = *(const f32x4*)(bias + colg), gvec = *(const f32x4*)(gp + colg);
        f32x4 v[2][16]; float mine = 0.f;
#pragma unroll
        for (int ai = 0; ai < 2; ++ai) {
            const size_t row0 = (size_t)(u.pm * BM + ai * HALF + wid * 16);
            f32x4 xr[16];
#pragma unroll
            for (int i = 0; i < 16; ++i) xr[i] = __builtin_nontemporal_load((const f32x4*)(x + (row0 + i) * ldc + colg));
#pragma unroll
            for (int m = 0; m < 4; ++m)
#pragma unroll
                for (int bj = 0; bj < 2; ++bj)
#pragma unroll
                    for (int n = 0; n < 2; ++n) *(PG8_LAS f32x4*)(T + (64 * wr + 16 * m + fr) * LPT + 128 * bj + 32 * wc + 16 * n + 4 * fq) = acc[ai][bj][m][n];
            __syncthreads();
#pragma unroll
            for (int i = 0; i < 16; ++i) { const f32x4 a = *(const PG8_LAS f32x4*)(T + (wid * 16 + i) * LPT + 4 * lane);
                const f32x4 vv = xr[i] + gvec * (a + bvec); v[ai][i] = vv;
                float sq = (vv.x * vv.x + vv.y * vv.y) + (vv.z * vv.z + vv.w * vv.w);
#pragma unroll
                for (int o = 1; o < 64; o <<= 1) sq += __shfl_xor(sq, o);
                mine = (lane == ai * 16 + i) ? sq : mine; }
            __syncthreads();
        }
        if (lane < 32) __hip_atomic_store(slots + (size_t)u.pn * M_total() + u.pm * BM + (lane >> 4) * HALF + wid * 16 + (lane & 15), mine, __ATOMIC_RELAXED, __HIP_MEMORY_SCOPE_AGENT);
        asm volatile("s_waitcnt vmcnt(0)" ::: "memory");
        __syncthreads();
        if (tid == 0) {
            __builtin_amdgcn_fence(__ATOMIC_RELEASE, "agent");
            asm volatile("s_waitcnt vmcnt(0)" ::: "memory");
            unsigned* c = cnt + 64 * u.pm;
            (void)__hip_atomic_fetch_add(c, 1u, __ATOMIC_RELAXED, __HIP_MEMORY_SCOPE_AGENT);
            unsigned sp = 0;
            while (__hip_atomic_load(c, __ATOMIC_RELAXED, __HIP_MEMORY_SCOPE_AGENT) < (unsigned)nN) { __builtin_amdgcn_s_sleep(1); if (++sp > (1u << 22)) break; }
            __builtin_amdgcn_fence(__ATOMIC_ACQUIRE, "agent");
            asm volatile("s_waitcnt vmcnt(0)" ::: "memory");
        }
        __syncthreads();
        float rl; { float sacc = 0.f; const size_t so = (size_t)u.pm * BM + ((lane >> 4) & 1) * HALF + wid * 16 + (lane & 15);
            for (int p = 0; p < nN; ++p) sacc += __hip_atomic_load(slots + (size_t)p * M_total() + so, __ATOMIC_RELAXED, __HIP_MEMORY_SCOPE_AGENT);
            rl = rsqrtf(sacc * (1.f / (float)ldc) + eps); }
        const f32x4 fvec = *(const f32x4*)(fg + colg);
#pragma unroll
        for (int ai = 0; ai < 2; ++ai) {
            const size_t row0 = (size_t)(u.pm * BM + ai * HALF + wid * 16);
#pragma unroll
            for (int i = 0; i < 16; ++i) { const float rstd = __shfl(rl, ai * 16 + i);
                __builtin_nontemporal_store(v[ai][i] * rstd * fvec, (f32x4*)(out + (row0 + i) * ldc + colg)); }
        }
    }
    int Mtot;
    __device__ __forceinline__ size_t M_total() const { return (size_t)Mtot; }
};

__device__ __forceinline__ float fexp(float x) { return __builtin_amdgcn_exp2f(x * 1.44269504f); }
__device__ __forceinline__ float fsigmoid(float x) { return __builtin_amdgcn_rcpf(1.f + __builtin_amdgcn_exp2f(x * -1.44269504f)); }
struct SingleUnit { Unit u0;
    __device__ __forceinline__ bool next(int i, Unit& u) const { if (i != 0) return false; u = u0; return true; }
    __device__ __forceinline__ void a_ready(const Unit&) const {}
    __device__ __forceinline__ void done(const Unit&) const {}
};
__host__ __device__ __forceinline__ int gate_row_map(int e) { const int n = e >> 8, c = e & 255, hf = c >> 7, cl = c & 127; return hf * 256 + (cl >> 4) * 32 + n * 16 + (cl & 15); }
struct EpiGateScan {
    static constexpr bool PERM = false, AFTER_DRAIN = true;
    static constexpr int LP = 132;
    const bf16_t* UC; const float* bgate; const float* lam; bf16_t* HLF; bf16_t* HLB; bf16_t* PF; bf16_t* PB; float* AGG; int seq, nchunk;
    __device__ __forceinline__ void operator()(const f32x4 (&)[2][2][4][2], const Unit&, int, int, int, int) const {}
    __device__ __forceinline__ void fused(f32x4 (&acc)[2][2][4][2], const Unit& u, int wr_, int wc_, int fr_, int fq_, PG8_LAS unsigned char* lds, int wid_, int lane_) const {
        int zero; asm volatile("v_mov_b32 %0, 0" : "=v"(zero));
        const int tid = (int)threadIdx.x + zero, lane = tid & 63, wid = __builtin_amdgcn_readfirstlane(tid >> 6), wr = wid >> 2, wc = wid & 3, fr = lane & 15, fq = lane >> 4;
        const int mi = u.pn >> 1, hf = u.pn & 1, dir = mi >> 2, head = mi & 3, chbase = head * 256 + hf * 128;
        bf16_t* HL = dir ? HLB : HLF; bf16_t* PP = dir ? PB : PF;
        PG8_LAS float* Aarr = (PG8_LAS float*)lds; PG8_LAS float* Barr = Aarr + 128 * LP; PG8_LAS float* SA = Barr + 128 * LP; PG8_LAS float* SH = SA + 512;
#pragma unroll
        for (int ai = 0; ai < 2; ++ai) {
            const int grow0 = u.pm * BM + HALF * ai;
        f32x4 br[2], bi[2], sp8[2];
#pragma unroll
            for (int bj = 0; bj < 2; ++bj) { const int cl0 = 64 * bj + 16 * wc + 4 * fq;
                br[bj] = *(const f32x4*)(bgate + mi * 512 + hf * 128 + cl0) * -1.44269504f; bi[bj] = *(const f32x4*)(bgate + mi * 512 + 256 + hf * 128 + cl0) * -1.44269504f;
                sp8[bj] = *(const f32x4*)(lam + dir * 1024 + chbase + cl0); }

#pragma unroll
            for (int m = 0; m < 4; ++m) { const int rl = 64 * wr + 16 * m + fr;
#pragma unroll
                for (int bj = 0; bj < 2; ++bj) { const int cl0 = 64 * bj + 16 * wc + 4 * fq;
                    const u32x2 uw = *(const u32x2*)(UC + (size_t)(grow0 + rl) * 1024 + chbase + cl0);
                    const float uu[4] = {__builtin_bit_cast(float, uw.x << 16), __builtin_bit_cast(float, uw.x & 0xffff0000u), __builtin_bit_cast(float, uw.y << 16), __builtin_bit_cast(float, uw.y & 0xffff0000u)};
                    const f32x4 gr = acc[ai][bj][m][0] + br[bj], gi = acc[ai][bj][m][1] + bi[bj];
                    f32x4 av, bxv;
#pragma unroll
                    for (int e = 0; e < 4; ++e) {
                        const float dr = 1.f + __builtin_amdgcn_exp2f(fminf(gr[e], 60.f)), di = 1.f + __builtin_amdgcn_exp2f(fminf(gi[e], 60.f));
                        const float inv = __builtin_amdgcn_rcpf(dr * di), r = inv * di, ig = inv * dr;
                        const float a = __builtin_amdgcn_exp2f(r * sp8[bj][e]);
                        const float m2 = __builtin_fmaf(-a, a, 1.f);
                        av[e] = a; bxv[e] = __builtin_amdgcn_sqrtf(m2) * ig * uu[e]; }
                    *(PG8_LAS f32x4*)(Aarr + rl * LP + cl0) = av; *(PG8_LAS f32x4*)(Barr + rl * LP + cl0) = bxv; }
                asm volatile("" ::: "memory"); }
            __syncthreads();
            { const int cl = tid & 127, sg = tid >> 7; float h = 0.f, P = 1.f;
              PG8_LAS float* pa = Aarr + (dir ? 127 - 32 * sg : 32 * sg) * LP + cl; PG8_LAS float* pb = Barr + (dir ? 127 - 32 * sg : 32 * sg) * LP + cl; const int st = dir ? -LP : LP;
              float va[32], vb[32];
#pragma unroll
              for (int k = 0; k < 32; ++k) { va[k] = pa[k * st]; vb[k] = pb[k * st]; }
#pragma unroll
              for (int k = 0; k < 32; ++k) { h = va[k] * h + vb[k]; P *= va[k]; va[k] = P; vb[k] = h; }
              SA[sg * 128 + cl] = P; SH[sg * 128 + cl] = h;
              __syncthreads();
              float cin = 0.f, pp = 1.f;
#pragma unroll
              for (int s2 = 0; s2 < 3; ++s2) { const float Ps = SA[s2 * 128 + cl], Hs = SH[s2 * 128 + cl]; if (s2 < sg) { cin = Hs + Ps * cin; pp *= Ps; } }
#pragma unroll
              for (int k = 0; k < 32; ++k) { pb[k * st] = vb[k] + va[k] * cin; pa[k * st] = va[k] * pp; } }
            __syncthreads();
#pragma unroll 1
            for (int k = 0; k < 4; ++k) { const int item = tid + 512 * k, o = item & 15, rl = item >> 4, p = dir ? 127 - rl : rl;
                const f32x4 a0 = *(const PG8_LAS f32x4*)(Aarr + rl * LP + 8 * o), a1 = *(const PG8_LAS f32x4*)(Aarr + rl * LP + 8 * o + 4);
                const f32x4 h0 = *(const PG8_LAS f32x4*)(Barr + rl * LP + 8 * o), h1 = *(const PG8_LAS f32x4*)(Barr + rl * LP + 8 * o + 4);
                const size_t go = (size_t)(grow0 + rl) * 1024 + chbase + 8 * o;
                u32x4 wh, wp; wh.x = cvt_pk_bf16(h0[0], h0[1]); wh.y = cvt_pk_bf16(h0[2], h0[3]); wh.z = cvt_pk_bf16(h1[0], h1[1]); wh.w = cvt_pk_bf16(h1[2], h1[3]);
                wp.x = cvt_pk_bf16(a0[0], a0[1]); wp.y = cvt_pk_bf16(a0[2], a0[3]); wp.z = cvt_pk_bf16(a1[0], a1[1]); wp.w = cvt_pk_bf16(a1[2], a1[3]);
                *(u32x4*)(HL + go) = wh; *(u32x4*)(PP + go) = wp;
                if (p == 127) { const int b = grow0 / seq, chunk = (grow0 % seq) / HALF;
                    float* ag = AGG + (size_t)(((b * nchunk + chunk) * 2 + dir) * 2) * 1024 + chbase + 8 * o;
                    *(f32x4*)(ag) = a0; *(f32x4*)(ag + 4) = a1; *(f32x4*)(ag + 1024) = h0; *(f32x4*)(ag + 1028) = h1; }
            }
            __syncthreads();
        }
    }
};

template <class Epi, class Sched, bool ALIGN_EPI = false, bool SP2 = false>
__device__ __forceinline__ void gemm_phase(PG8_LAS unsigned char* lds, const Gemm g, const Sched& S, const Epi& E) {
    int zero_; asm volatile("v_mov_b32 %0, 0" : "=v"(zero_));
    const int tid = (int)threadIdx.x + zero_, wid = __builtin_amdgcn_readfirstlane(tid >> 6), lane = tid & 63, wr = wid >> 2, wc = wid & 3, fr = lane & 15, fq = lane >> 4;
    const int K = g.K, nt = K / BK, lda = g.lda;
    unsigned voffA[2], voffB[2];
#pragma unroll
    for (int i = 0; i < 2; ++i) { int R, C; stage_rc(tid * 16 + i * 8192, R, C); const int Rb = Epi::PERM ? ((R & ~31) + perm32(R & 31)) : R;
        voffA[i] = (unsigned)(R * lda + C) * 2u; voffB[i] = (unsigned)(Rb * K + C) * 2u; }
    const size_t kstep = (size_t)(BK * 2);
    const size_t hsA = (size_t)HALF * lda * 2, hsB = (size_t)HALF * K * 2;
    const size_t tsA = 2 * hsA, tsB = 2 * hsB;
    const unsigned ldsw = (unsigned)wid * 1024u;
    const int aoff = lds_byte(wr * 64 + fr, fq * 8), boff = lds_byte(wc * 32 + fr, fq * 8);
#define PG8_SA(b, h) (((b) * 2 + (h)) * HTB)
#define PG8_SB(b, h) ((4 + (b) * 2 + (h)) * HTB)
#define PG8_STAGE(bufoff, gbase, voff) do { _Pragma("unroll") for (int _i = 0; _i < 2; ++_i) \
        __builtin_amdgcn_global_load_lds((const unsigned*)((const char*)(gbase) + (voff)[_i]), (PG8_LAS unsigned*)(lds + (bufoff) + ldsw + _i * 8192), 16, 0, 0); } while (0)
#define PG8_LDA(dst, b, h) do { _Pragma("unroll") for (int m = 0; m < 4; ++m) _Pragma("unroll") for (int k = 0; k < 2; ++k) dst[m][k] = *(const PG8_LAS bf16x8*)(lds + PG8_SA(b, h) + aoff + m * 2048 + k * 1024); } while (0)
#define PG8_LDB(dst, b, h) do { _Pragma("unroll") for (int n = 0; n < 2; ++n) _Pragma("unroll") for (int k = 0; k < 2; ++k) dst[n][k] = *(const PG8_LAS bf16x8*)(lds + PG8_SB(b, h) + boff + n * 2048 + k * 1024); } while (0)
#define PG8_MMA(ai, bj, At, Bt) do { __builtin_amdgcn_s_setprio(1); _Pragma("unroll") for (int m = 0; m < 4; ++m) _Pragma("unroll") for (int n = 0; n < 2; ++n) _Pragma("unroll") for (int k = 0; k < 2; ++k) \
        acc[ai][bj][m][n] = __builtin_amdgcn_mfma_f32_16x16x32_bf16(Bt[n][k], At[m][k], acc[ai][bj][m][n], 0, 0, 0); __builtin_amdgcn_s_setprio(0); } while (0)
#define PG8_WAIT_V(n) asm volatile("s_waitcnt vmcnt(" #n ")" ::: "memory")
#define PG8_WAIT_L(n) asm volatile("s_waitcnt lgkmcnt(" #n ")" ::: "memory")
#define PG8_BAR __builtin_amdgcn_s_barrier()
#define PG8_SCHED __builtin_amdgcn_sched_barrier(0)
#define PG8_APTR(u) ((const char*)g.A + (size_t)(u).pm * tsA + (size_t)((((u).pn >> g.ashift) & g.amask) * K) * 2)
    Unit cur, nxt; int ui = 0;
    if (!S.next(0, cur)) return;
    f32x4 acc[2][2][4][2];
#pragma unroll
    for (int a = 0; a < 2; ++a)
#pragma unroll
        for (int b = 0; b < 2; ++b)
#pragma unroll
            for (int m = 0; m < 4; ++m)
#pragma unroll
                for (int n = 0; n < 2; ++n) acc[a][b][m][n] = (f32x4){0.f, 0.f, 0.f, 0.f};
    bf16x8 At[4][2], B0[2][2], B1[2][2];
    const char* cA = PG8_APTR(cur); const char* cB = (const char*)g.Bt + (size_t)cur.pn * tsB;
    S.a_ready(cur);
    if constexpr (SP2) {
        PG8_STAGE(PG8_SB(0, 0), cB, voffB); PG8_STAGE(PG8_SB(0, 1), cB + hsB, voffB); PG8_STAGE(PG8_SA(0, 0), cA, voffA); PG8_STAGE(PG8_SA(0, 1), cA + hsA, voffA);
        if (wr == 1) PG8_BAR;
        PG8_WAIT_V(2); PG8_BAR;
        PG8_STAGE(PG8_SB(1, 0), cB + kstep, voffB); PG8_STAGE(PG8_SA(1, 0), cA + kstep, voffA); PG8_STAGE(PG8_SB(1, 1), cB + hsB + kstep, voffB);
        PG8_WAIT_V(6); PG8_BAR;
    } else {
        PG8_STAGE(PG8_SB(0, 0), cB, voffB); PG8_STAGE(PG8_SA(0, 0), cA, voffA); PG8_STAGE(PG8_SB(0, 1), cB + hsB, voffB); PG8_STAGE(PG8_SA(0, 1), cA + hsA, voffA);
        if (wr == 1) PG8_BAR;
        PG8_WAIT_V(4); PG8_BAR;
        PG8_STAGE(PG8_SB(1, 0), cB + kstep, voffB); PG8_STAGE(PG8_SA(1, 0), cA + kstep, voffA); PG8_STAGE(PG8_SB(1, 1), cB + hsB + kstep, voffB);
        PG8_WAIT_V(6); PG8_BAR;
    }
    for (;;) {
        const bool has_next = S.next(ui + 1, nxt);
        const char* nA = has_next ? PG8_APTR(nxt) : cA; const char* nB = has_next ? (const char*)g.Bt + (size_t)nxt.pn * tsB : cB;
        for (int t = 0; t < nt; t += 2) {
            const bool last = (t == nt - 2);
            const char* a1 = cA + (size_t)(t + 1) * kstep;
            const char* a2 = last ? nA : cA + (size_t)(t + 2) * kstep; const char* b2 = last ? nB : cB + (size_t)(t + 2) * kstep;
            const char* a3 = a2 + kstep; const char* b3 = b2 + kstep;
            if (last && has_next) S.a_ready(nxt);
            if constexpr (SP2) {
            PG8_LDB(B0, 0, 0); PG8_LDB(B1, 0, 1); PG8_SCHED; PG8_LDA(At, 0, 0); PG8_STAGE(PG8_SA(1, 1), a1 + hsA, voffA);
            PG8_WAIT_V(8); PG8_WAIT_L(0); PG8_BAR; PG8_MMA(0, 0, At, B0); PG8_MMA(0, 1, At, B1); PG8_BAR; PG8_SCHED;
            PG8_LDA(At, 0, 1); PG8_STAGE(PG8_SB(0, 0), b2, voffB); PG8_STAGE(PG8_SB(0, 1), b2 + hsB, voffB); PG8_STAGE(PG8_SA(0, 0), a2, voffA);
            PG8_WAIT_V(8); PG8_WAIT_L(0); PG8_BAR; PG8_MMA(1, 0, At, B0); PG8_MMA(1, 1, At, B1); PG8_BAR; PG8_SCHED;
            PG8_LDB(B0, 1, 0); PG8_LDB(B1, 1, 1); PG8_SCHED; PG8_LDA(At, 1, 0); PG8_STAGE(PG8_SA(0, 1), a2 + hsA, voffA);
            PG8_WAIT_V(8); PG8_WAIT_L(0); PG8_BAR; PG8_MMA(0, 0, At, B0); PG8_MMA(0, 1, At, B1); PG8_BAR; PG8_SCHED;
            PG8_LDA(At, 1, 1); PG8_STAGE(PG8_SB(1, 0), b3, voffB); PG8_STAGE(PG8_SB(1, 1), b3 + hsB, voffB); PG8_STAGE(PG8_SA(1, 0), a3, voffA);
            PG8_WAIT_V(8); PG8_WAIT_L(0); PG8_BAR; PG8_MMA(1, 0, At, B0); PG8_MMA(1, 1, At, B1); PG8_BAR; PG8_SCHED;
            } else {
            PG8_LDB(B0, 0, 0); PG8_SCHED; PG8_LDA(At, 0, 0); PG8_STAGE(PG8_SA(1, 1), a1 + hsA, voffA);
            PG8_WAIT_L(8); PG8_BAR; PG8_WAIT_L(0); PG8_MMA(0, 0, At, B0); PG8_BAR; PG8_SCHED;
            PG8_LDB(B1, 0, 1); PG8_STAGE(PG8_SB(0, 0), b2, voffB);
            PG8_BAR; PG8_WAIT_L(0); PG8_MMA(0, 1, At, B1); PG8_BAR;
            PG8_LDA(At, 0, 1); PG8_STAGE(PG8_SA(0, 0), a2, voffA);
            PG8_BAR; PG8_WAIT_L(0); PG8_MMA(1, 0, At, B0); PG8_BAR; PG8_SCHED;
            PG8_STAGE(PG8_SB(0, 1), b2 + hsB, voffB);
            PG8_WAIT_V(6); PG8_BAR; PG8_MMA(1, 1, At, B1); PG8_BAR;
            PG8_LDB(B0, 1, 0); PG8_SCHED; PG8_LDA(At, 1, 0); PG8_STAGE(PG8_SA(0, 1), a2 + hsA, voffA);
            PG8_WAIT_L(8); PG8_BAR; PG8_WAIT_L(0); PG8_MMA(0, 0, At, B0); PG8_BAR; PG8_SCHED;
            PG8_LDB(B1, 1, 1); PG8_STAGE(PG8_SB(1, 0), b3, voffB);
            PG8_BAR; PG8_WAIT_L(0); PG8_MMA(0, 1, At, B1); PG8_BAR;
            PG8_LDA(At, 1, 1); PG8_STAGE(PG8_SA(1, 0), a3, voffA);
            PG8_BAR; PG8_WAIT_L(0); PG8_MMA(1, 0, At, B0); PG8_BAR; PG8_SCHED;
            PG8_STAGE(PG8_SB(1, 1), b3 + hsB, voffB);
            PG8_WAIT_V(6); PG8_BAR; PG8_MMA(1, 1, At, B1); PG8_BAR;
            }
        }
        if constexpr (ALIGN_EPI) { if (wr == 0) PG8_BAR; }
        if constexpr (!Epi::AFTER_DRAIN) { E(acc, cur, wr, wc, fr, fq); S.done(cur); }
        if (!has_next) break;
#pragma unroll
        for (int a = 0; a < 2; ++a)
#pragma unroll
            for (int b = 0; b < 2; ++b)
#pragma unroll
                for (int m = 0; m < 4; ++m)
#pragma unroll
                    for (int n = 0; n < 2; ++n) acc[a][b][m][n] = (f32x4){0.f, 0.f, 0.f, 0.f};
        cur = nxt; cA = nA; cB = nB; ++ui;
        if constexpr (ALIGN_EPI) { if (wr == 1) PG8_BAR; }
    }
    PG8_WAIT_V(0);
    if constexpr (!ALIGN_EPI) { if (wr == 0) PG8_BAR; }
    PG8_BAR;
    if constexpr (Epi::AFTER_DRAIN) { E.fused(acc, cur, wr, wc, fr, fq, lds, wid, lane); S.done(cur); }
#undef PG8_APTR
#undef PG8_SA
#undef PG8_SB
#undef PG8_STAGE
#undef PG8_LDA
#undef PG8_LDB
#undef PG8_MMA
#undef PG8_WAIT_V
#undef PG8_WAIT_L
#undef PG8_BAR
#undef PG8_SCHED
}
}

constexpr int NWAVES = 8, NTHR = NWAVES * 64;
constexpr int DM = 2048, NB = 4, SEQ = 2048, MROWS = NB * SEQ;
constexpr int WP = 1024, WL = 1024, NZ = 4096;
constexpr int CHUNK = 128, NCHUNK = SEQ / CHUNK;
constexpr float EPS = 1e-6f;
constexpr int KC_MOD = 8;

constexpr size_t MiB = 1u << 20;
constexpr size_t WS_MODP = 1 * MiB;
constexpr size_t WS_GATE = 2 * MiB;
constexpr size_t WS_SLOT = 3 * MiB;
constexpr size_t WS_SP8 = 2 * MiB + 512 * 1024;
constexpr size_t WS_AGG = 4 * MiB;
constexpr size_t WS_WIN = 8 * MiB;
constexpr size_t WS_WOUT = 24 * MiB;
constexpr size_t WS_WGATE = 32 * MiB;
constexpr size_t WS_WPOOL = 34 * MiB;
constexpr size_t WS_H = 36 * MiB;
constexpr size_t WS_Z = 68 * MiB;
constexpr size_t WS_UC = 132 * MiB;
constexpr size_t WS_POOLED = 148 * MiB;
constexpr size_t WS_GT = 164 * MiB;
constexpr size_t WS_YP = 228 * MiB;
constexpr size_t WS_END = 244 * MiB;
constexpr size_t WS_HLF = WS_H, WS_HLB = WS_H + 16 * MiB, WS_PF = WS_GT + 32 * MiB, WS_PB = WS_WIN, WS_A2 = WS_GT;

constexpr int LDS_BYTES = 147456;

#define LAS __attribute__((address_space(3)))
typedef unsigned short bf16;
typedef float f32x4 __attribute__((ext_vector_type(4)));
typedef unsigned u32x4 __attribute__((ext_vector_type(4)));
typedef unsigned u32x2 __attribute__((ext_vector_type(2)));

__device__ __forceinline__ unsigned f2bf(float f) { unsigned u = __builtin_bit_cast(unsigned, f); return (u + 0x7fffu + ((u >> 16) & 1u)) >> 16; }
__device__ __forceinline__ unsigned pk2(float lo, float hi) { return pg8::cvt_pk_bf16(lo, hi); }
__device__ __forceinline__ float bflo(unsigned w) { return __builtin_bit_cast(float, w << 16); }
__device__ __forceinline__ float bfhi(unsigned w) { return __builtin_bit_cast(float, w & 0xffff0000u); }
__device__ __forceinline__ float bf1(bf16 h) { return __builtin_bit_cast(float, (unsigned)h << 16); }
__device__ __forceinline__ void unpack8(const u32x4 w, float (&f)[8]) { f[0] = bflo(w.x); f[1] = bfhi(w.x); f[2] = bflo(w.y); f[3] = bfhi(w.y); f[4] = bflo(w.z); f[5] = bfhi(w.z); f[6] = bflo(w.w); f[7] = bfhi(w.w); }
__device__ __forceinline__ u32x4 pack8(const float (&f)[8]) { u32x4 w; w.x = pk2(f[0], f[1]); w.y = pk2(f[2], f[3]); w.z = pk2(f[4], f[5]); w.w = pk2(f[6], f[7]); return w; }
__device__ __forceinline__ float wave_sum(float v) {
#pragma unroll
    for (int o = 1; o < 64; o <<= 1) v += __shfl_xor(v, o);
    return v;
}
__device__ __forceinline__ float sigmoidf_(float x) { return pg8::fsigmoid(x); }
__device__ __forceinline__ float siluf_(float x) { return x * pg8::fsigmoid(x); }

#define XB_TMO      128
#define XB_XCNT(j)  (256  + 64 * (j))
#define XB_XSUB(j)  (1280 + 64 * (j))
#define XB_XGEN(j)  (2304 + 64 * (j))
#define XB_TOP      3328
#define XB_TOPGEN   3392
#define XCD_BAR_WORDS 3456
#define XB_SPIN_CAP (1u << 18)
__device__ __forceinline__ unsigned xb_ld(unsigned* p)              { return __hip_atomic_load(p, __ATOMIC_RELAXED, __HIP_MEMORY_SCOPE_AGENT); }
__device__ __forceinline__ unsigned xb_add(unsigned* p, unsigned v) { return __hip_atomic_fetch_add(p, v, __ATOMIC_RELAXED, __HIP_MEMORY_SCOPE_AGENT); }
__device__ __forceinline__ unsigned xb_xcc_id() { return (unsigned)__builtin_amdgcn_s_getreg((3 << 11) | 20) & 0xFu; }
#define XB_SPIN(cond, bar) do { unsigned _sp = 0; while (cond) { __builtin_amdgcn_s_sleep(1); \
    if ((++_sp & 255u) == 0u) { if (xb_ld(&(bar)[XB_TMO])) break; if (_sp > XB_SPIN_CAP) { atomicAdd(&(bar)[XB_TMO], 1u); break; } } } } while (0)
struct XcdBarrier { unsigned* bar; unsigned x; volatile LAS unsigned* st; };
__device__ __forceinline__ XcdBarrier xcd_barrier_post(unsigned* bar, volatile LAS unsigned* st) {
    XcdBarrier b; b.bar = bar; b.x = xb_xcc_id(); b.st = st;
    if (threadIdx.x == 0) (void)xb_add(&bar[XB_XCNT(b.x)], 1u);
    return b;
}
__device__ __forceinline__ void xcd_barrier_complete(unsigned* bar, unsigned x, unsigned& nloc, unsigned& nx) {
    const unsigned G = gridDim.x * gridDim.y * gridDim.z;
    unsigned sum, cnt, mine, sp = 0u;
    for (;;) {
        sum = 0u; cnt = 0u; mine = 0u;
#pragma unroll
        for (unsigned j = 0; j < 16; ++j) { const unsigned c = xb_ld(&bar[XB_XCNT(j)]); sum += c; cnt += (c > 0u) ? 1u : 0u; mine = (j == x) ? c : mine; }
        if (sum == G) break;
        __builtin_amdgcn_s_sleep(1);
        if ((++sp & 255u) == 0u) { if (xb_ld(&bar[XB_TMO])) break; if (sp > XB_SPIN_CAP) { atomicAdd(&bar[XB_TMO], 1u); break; } }
    }
    nloc = mine > 0u ? mine : 1u; nx = cnt > 0u ? cnt : 1u;
}
__device__ __forceinline__ void xcd_barrier(const XcdBarrier& b) {
    asm volatile("s_waitcnt vmcnt(0)" ::: "memory");
    __syncthreads();
    if (threadIdx.x == 0) {
        unsigned* bar = b.bar;
        __builtin_amdgcn_s_waitcnt(0);
        unsigned nloc = b.st[0], nx = b.st[1];
        if (nloc == 0u) { xcd_barrier_complete(bar, b.x, nloc, nx); b.st[0] = nloc; b.st[1] = nx; }
        const unsigned old = xb_add(&bar[XB_XSUB(b.x)], 1u);
        const unsigned gen = old / nloc;
        if (old + 1u == (gen + 1u) * nloc) {
            __builtin_amdgcn_fence(__ATOMIC_RELEASE, "agent");
            asm volatile("s_waitcnt vmcnt(0)" ::: "memory");
            const unsigned og = xb_add(&bar[XB_TOP], 1u);
            const unsigned tg = og / nx;
            if (og + 1u == (tg + 1u) * nx) xb_add(&bar[XB_TOPGEN], 1u);
            else XB_SPIN(xb_ld(&bar[XB_TOPGEN]) == tg, bar);
            __builtin_amdgcn_fence(__ATOMIC_ACQUIRE, "agent");
            xb_add(&bar[XB_XGEN(b.x)], 1u);
            asm volatile("s_waitcnt vmcnt(0)" ::: "memory");
        } else {
            XB_SPIN(xb_ld(&bar[XB_XGEN(b.x)]) == gen, bar);
            __builtin_amdgcn_fence(__ATOMIC_ACQUIRE, "agent");
            asm volatile("s_waitcnt vmcnt(0)" ::: "memory");
        }
    }
    __syncthreads();
}

struct Args {
    const float* in[20]; float* out; unsigned char* ws; int ph_lo, ph_hi;
};

__device__ __forceinline__ void p0_transpose_item(const float* W, int K, int N, bf16* WT, int row_off, LAS float* scr, int item, int lane, bool gmap = false, float wscale = 1.f, bool pmap = false) {
    const int nblk = N / 32, kb = item / nblk, nb = item % nblk, k0 = 64 * kb, n0 = 32 * nb;
    float tv[32];
#pragma unroll
    for (int i = 0; i < 32; ++i) { const int kk = 2 * i + (lane >> 5); tv[i] = __builtin_nontemporal_load(W + (size_t)(k0 + kk) * N + n0 + (lane & 31)); }
#pragma unroll
    for (int i = 0; i < 32; ++i) { const int kk = 2 * i + (lane >> 5); scr[kk * 33 + (lane & 31)] = tv[i]; }
    asm volatile("s_waitcnt lgkmcnt(0)" ::: "memory");
    const int c = lane & 7;
#pragma unroll
    for (int j = 0; j < 4; ++j) { const int n = (lane >> 3) + 8 * j; const LAS float* s = scr + (8 * c) * 33 + n;
        u32x4 o; o.x = pk2(s[0 * 33] * wscale, s[1 * 33] * wscale); o.y = pk2(s[2 * 33] * wscale, s[3 * 33] * wscale); o.z = pk2(s[4 * 33] * wscale, s[5 * 33] * wscale); o.w = pk2(s[6 * 33] * wscale, s[7 * 33] * wscale);
        if (gmap) {
            const int e = n0 + n, g = e >> 8, ch = e & 255, k8 = k0 + 8 * c;
            *(u32x4*)(WT + (size_t)row_off * K + (size_t)((((g * 8 + (ch >> 5)) * 16 + (k8 >> 4)) * 64 + (ch & 31) + 32 * ((k8 >> 3) & 1)) * 8)) = o;
        } else if (pmap) {
            const int e = n0 + n, k8 = k0 + 8 * c;
            *(u32x4*)(WT + (size_t)row_off * K + (size_t)((((e >> 5) * 16 + (k8 >> 4)) * 64 + (e & 31) + 32 * ((k8 >> 3) & 1)) * 8)) = o;
        } else *(u32x4*)(WT + (size_t)(row_off + n0 + n) * K + k0 + 8 * c) = o; }
    asm volatile("s_waitcnt lgkmcnt(0)" ::: "memory");
}

template <int W> __device__ __forceinline__ void pool_slide_item(const bf16* Z, bf16* POOLED, int gI, int tokoct, int v) {
    constexpr int LO = W / 2, HI = W - LO - 1, NR = W + 7;
    const int c0 = gI * 256 + v * 8, row0 = tokoct * 8, t0 = row0 & (SEQ - 1);
    const bf16* zp = Z + (size_t)(row0 - t0) * NZ + c0;
    u32x4 raw[NR];
#pragma unroll
    for (int k = 0; k < NR; ++k) { int tt = t0 - LO + k; tt = tt < 0 ? 0 : (tt > SEQ - 1 ? SEQ - 1 : tt); raw[k] = *(const u32x4*)(zp + (size_t)tt * NZ); }
    float S[8] = {0.f, 0.f, 0.f, 0.f, 0.f, 0.f, 0.f, 0.f}, f[8];
#pragma unroll
    for (int k = 0; k < W; ++k) { const int tt = t0 - LO + k; const float wgt = (tt >= 0 && tt < SEQ) ? 1.f : 0.f; unpack8(raw[k], f);
#pragma unroll
        for (int e = 0; e < 8; ++e) S[e] += wgt * f[e]; }
#pragma unroll
    for (int j = 0; j < 8; ++j) {
        const int t = t0 + j, st = (t - LO) < 0 ? 0 : (t - LO), en = ((t + HI) > (SEQ - 1) ? (SEQ - 1) : (t + HI)) + 1;
        const float inv = __builtin_amdgcn_rcpf((float)(en - st));
        float o[8]; unpack8(raw[j + LO], f);
#pragma unroll
        for (int e = 0; e < 8; ++e) o[e] = S[e] * inv - f[e];
        *(u32x4*)(POOLED + (size_t)(row0 + j) * WP + c0) = pack8(o);
        if (j < 7) {
            { const int tt = t0 - LO + j + W; const float wgt = (tt >= 0 && tt < SEQ) ? 1.f : 0.f; unpack8(raw[j + W], f);
#pragma unroll
              for (int e = 0; e < 8; ++e) S[e] += wgt * f[e]; }
            { const int tt = t0 - LO + j; const float wgt = (tt >= 0 && tt < SEQ) ? 1.f : 0.f; unpack8(raw[j], f);
#pragma unroll
              for (int e = 0; e < 8; ++e) S[e] -= wgt * f[e]; }
        }
    }
}

typedef float f32x16 __attribute__((ext_vector_type(16)));
typedef short bf16x8v __attribute__((ext_vector_type(8)));
template <int DIR> __device__ __forceinline__ void gate_dir(LAS unsigned char* lds, const bf16* WGT, const float* bgate, const float* sp8t, bf16* HL, bf16* PP, float* AGG,
                                                             int tid, int lane, int wv, int hd, int row0, int b, int chunk) {
    const int r = lane & 31, h = lane >> 5, c = 32 * wv + r, mi = DIR * 4 + hd;
    bf16x8v Bf[2][16];
#pragma unroll
    for (int g = 0; g < 2; ++g) { const bf16* wfr = WGT + (size_t)mi * 512 * 256 + (size_t)((g * 8 + wv) * 16) * 512 + lane * 8;
#pragma unroll
        for (int ks = 0; ks < 16; ++ks) Bf[g][ks] = *(const bf16x8v*)(wfr + ks * 512); }
    const float brs = bgate[mi * 512 + c] * -1.44269504f, bis = bgate[mi * 512 + 256 + c] * -1.44269504f, sp = sp8t[DIR * WL + hd * 256 + c];
    float Pc = 1.f, Hc = 0.f;
#pragma unroll 1
    for (int mi2 = 0; mi2 < 4; ++mi2) {
        int zi; asm volatile("v_mov_b32 %0, 0" : "=v"(zi));
        const int mt = DIR ? 3 - mi2 : mi2, arow = 32 * mt + r;
        f32x16 ar, ai;
#pragma unroll
        for (int q = 0; q < 16; ++q) { ar[q] = 0.f; ai[q] = 0.f; }
        LAS const unsigned char* abase = lds + arow * 528 + h * 16;
        const int hz = h + zi;
        bf16x8v Afc = *(LAS const bf16x8v*)(abase);
#pragma unroll
        for (int ks = 0; ks < 16; ++ks) { bf16x8v Afn = Afc;
            if (ks < 15) Afn = *(LAS const bf16x8v*)(abase + (ks + 1) * 32);
            ar = __builtin_amdgcn_mfma_f32_32x32x16_bf16(Afc, Bf[0][ks], ar, 0, 0, 0); ai = __builtin_amdgcn_mfma_f32_32x32x16_bf16(Afc, Bf[1][ks], ai, 0, 0, 0);
            Afc = Afn; }
        unsigned short ub[16];
        { LAS const unsigned char* ubase = lds + (32 * mt + 4 * hz) * 528 + c * 2;
#pragma unroll
          for (int q = 0; q < 16; ++q) ub[q] = *(LAS const unsigned short*)(ubase + ((q & 3) + 8 * (q >> 2)) * 528); }
        float av[16], bxv[16];
#pragma unroll
        for (int q = 0; q < 16; ++q) { const float u = bf1(ub[q]);
            const float dr = 1.f + __builtin_amdgcn_exp2f(fminf(ar[q] + brs, 60.f)), di = 1.f + __builtin_amdgcn_exp2f(fminf(ai[q] + bis, 60.f));
            const float inv = __builtin_amdgcn_rcpf(dr * di), rr = inv * di, ig = inv * dr;
            const float a = __builtin_amdgcn_exp2f(rr * sp), m2 = __builtin_fmaf(-a, a, 1.f);
            av[q] = a; bxv[q] = __builtin_amdgcn_sqrtf(m2) * ig * u; }
        float Pg[4], Hg[4], Pp[4], Hp[4], cinH[4], cinP[4];
#pragma unroll
        for (int g = 0; g < 4; ++g) { float P = 1.f, H = 0.f;
#pragma unroll
            for (int jj = 0; jj < 4; ++jj) { const int q = 4 * g + (DIR ? 3 - jj : jj); H = av[q] * H + bxv[q]; P *= av[q]; bxv[q] = H; av[q] = P; }
            Pg[g] = P; Hg[g] = H; Pp[g] = __shfl_xor(P, 32); Hp[g] = __shfl_xor(H, 32); }
#pragma unroll
        for (int gg = 0; gg < 4; ++gg) { const int g = DIR ? 3 - gg : gg;
            const float P0 = h ? Pp[g] : Pg[g], H0 = h ? Hp[g] : Hg[g], P1 = h ? Pg[g] : Pp[g], H1 = h ? Hg[g] : Hp[g];
            if (DIR == 0) { const float Hca = H0 + P0 * Hc, Pca = Pc * P0; cinH[g] = h ? Hca : Hc; cinP[g] = h ? Pca : Pc; Hc = H1 + P1 * Hca; Pc = Pca * P1; }
            else          { const float Hca = H1 + P1 * Hc, Pca = Pc * P1; cinH[g] = h ? Hc : Hca; cinP[g] = h ? Pc : Pca; Hc = H0 + P0 * Hca; Pc = Pca * P0; } }
        { unsigned short* hb = (unsigned short*)HL + (size_t)(row0 + 32 * mt) * WL + hd * 256; unsigned short* pb = (unsigned short*)PP + (size_t)(row0 + 32 * mt) * WL + hd * 256;
          const int loff = 4 * hz * WL + c;
          int zo; asm volatile("v_mov_b32 %0, 0" : "=v"(zo) : "v"(cinH[0]));
          LAS unsigned short* park = (LAS unsigned short*)(lds + 69632) + ((wv * 4 + mt) * 16) * 64 + lane + zo;
#pragma unroll
          for (int q = 0; q < 16; ++q) { const int tl = (q & 3) + 8 * (q >> 2); float ho = bxv[q] + av[q] * cinH[q >> 2]; const float po = av[q] * cinP[q >> 2];
              if (DIR == 1) ho += bf1(park[q * 64]);
              const unsigned w = pg8::cvt_pk_bf16(ho, po);
              if (DIR == 0) park[q * 64] = (unsigned short)(w & 0xffffu); else (hb + tl * WL)[loff] = (unsigned short)(w & 0xffffu);
              (pb + tl * WL)[loff] = (unsigned short)(w >> 16); } }
    }
    if (h == 0) { float* ag = AGG + (size_t)(((b * NCHUNK + chunk) * 2 + DIR) * 2) * WL + hd * 256 + c; ag[0] = Pc; ag[WL] = Hc; }
}
__device__ __forceinline__ void gate_item(LAS unsigned char* lds, const bf16* Zu, const float* conv_w, const float* conv_b, const bf16* WGT, const float* bgate, const float* sp8t, bf16* HLF, bf16* HLB, bf16* PF, bf16* PB, float* AGG, int it) {
    int z; asm volatile("v_mov_b32 %0, 0" : "=v"(z));
    const int tid = (int)threadIdx.x + z, lane = tid & 63, wv = __builtin_amdgcn_readfirstlane(tid >> 6);
    const int tile = it >> 2, hd = it & 3, row0 = tile * 128, b = row0 / SEQ, chunk = (row0 % SEQ) / CHUNK;
    __syncthreads();
    {
        const int t0 = row0 % SEQ;
#pragma unroll 4
        for (int i = 0; i < 8; ++i) { const int id = tid + NTHR * i, row = id >> 5, kc = id & 31, t = t0 + row, c0 = hd * 256 + kc * 8;
            const bf16* zp = Zu + (size_t)(row0 - t0) * NZ + c0;
            u32x4 raw[4];
#pragma unroll
            for (int k = 0; k < 4; ++k) { int tt = t + k - 2; tt = tt < 0 ? 0 : (tt > SEQ - 1 ? SEQ - 1 : tt); raw[k] = *(const u32x4*)(zp + (size_t)tt * NZ); }
            float a8[8], f[8];
            { const f32x4 b0 = *(const f32x4*)(conv_b + c0), b1 = *(const f32x4*)(conv_b + c0 + 4); a8[0] = b0.x; a8[1] = b0.y; a8[2] = b0.z; a8[3] = b0.w; a8[4] = b1.x; a8[5] = b1.y; a8[6] = b1.z; a8[7] = b1.w; }
#pragma unroll
            for (int k = 0; k < 4; ++k) { const int tt = t + k - 2; const float wgt = (tt >= 0 && tt < SEQ) ? 1.f : 0.f; unpack8(raw[k], f);
                const f32x4 w0 = *(const f32x4*)(conv_w + k * WL + c0) * wgt, w1 = *(const f32x4*)(conv_w + k * WL + c0 + 4) * wgt;
                a8[0] += w0.x * f[0]; a8[1] += w0.y * f[1]; a8[2] += w0.z * f[2]; a8[3] += w0.w * f[3]; a8[4] += w1.x * f[4]; a8[5] += w1.y * f[5]; a8[6] += w1.z * f[6]; a8[7] += w1.w * f[7]; }
            *(LAS u32x4*)(lds + row * 528 + (kc << 4)) = pack8(a8); }
    }
    __syncthreads();
    gate_dir<0>(lds, WGT, bgate, sp8t, HLF, PF, AGG, tid, lane, wv, hd, row0, b, chunk);
    gate_dir<1>(lds, WGT, bgate, sp8t, HLF, PB, AGG, tid, lane, wv, hd, row0, b, chunk);
}

template <int W> __device__ __forceinline__ void pooled_tile_to_lds(const bf16* Zg, LAS unsigned char* lds, int row0, int t0, int tid) {
    constexpr int LO = W / 2, HI = W - LO - 1, TOK = 4, NR = W + TOK - 1;
#pragma unroll 1
    for (int itx = 0; itx < 2; ++itx) {
        const int id = tid + NTHR * itx, tloc0 = (id >> 5) * TOK, v = id & 31, t = t0 + tloc0;
        const bf16* zp = Zg + (size_t)(row0 - t0) * NZ + v * 8;
        u32x4 raw[NR];
#pragma unroll
        for (int k = 0; k < NR; ++k) { int tt = t - LO + k; tt = tt < 0 ? 0 : (tt > SEQ - 1 ? SEQ - 1 : tt); raw[k] = *(const u32x4*)(zp + (size_t)tt * NZ); }
        float S[8] = {0.f, 0.f, 0.f, 0.f, 0.f, 0.f, 0.f, 0.f}, f[8];
#pragma unroll
        for (int k = 0; k < W; ++k) { const int tt = t - LO + k; const float wgt = (tt >= 0 && tt < SEQ) ? 1.f : 0.f; unpack8(raw[k], f);
#pragma unroll
            for (int e = 0; e < 8; ++e) S[e] += wgt * f[e]; }
#pragma unroll
        for (int j = 0; j < TOK; ++j) {
            const int tj = t + j, st = (tj - LO) < 0 ? 0 : (tj - LO), en = ((tj + HI) > (SEQ - 1) ? (SEQ - 1) : (tj + HI)) + 1;
            const float inv = __builtin_amdgcn_rcpf((float)(en - st));
            float o[8]; unpack8(raw[j + LO], f);
#pragma unroll
            for (int e = 0; e < 8; ++e) o[e] = S[e] * inv - f[e];
            *(LAS u32x4*)(lds + (tloc0 + j) * 528 + (v << 4)) = pack8(o);
            if (j < TOK - 1) {
                { const int tt = t - LO + j + W; const float wgt = (tt >= 0 && tt < SEQ) ? 1.f : 0.f; unpack8(raw[j + W], f);
#pragma unroll
                  for (int e = 0; e < 8; ++e) S[e] += wgt * f[e]; }
                { const int tt = t - LO + j; const float wgt = (tt >= 0 && tt < SEQ) ? 1.f : 0.f; unpack8(raw[j], f);
#pragma unroll
                  for (int e = 0; e < 8; ++e) S[e] -= wgt * f[e]; }
            }
        }
    }
}
__device__ __forceinline__ void pool_item(LAS unsigned char* lds, const bf16* Z, const bf16* WPF, const float* b_pool, const float* pool_scale, bf16* YP, int it) {
    int z; asm volatile("v_mov_b32 %0, 0" : "=v"(z));
    const int tid = (int)threadIdx.x + z, lane = tid & 63, wv = __builtin_amdgcn_readfirstlane(tid >> 6), r = lane & 31, h = lane >> 5, c = 32 * wv + r;
    const int tile = it >> 2, g = it & 3, row0 = tile * 128, t0 = row0 % SEQ;
    __syncthreads();
    if (g == 0) pooled_tile_to_lds<2>(Z, lds, row0, t0, tid);
    else if (g == 1) pooled_tile_to_lds<4>(Z + 256, lds, row0, t0, tid);
    else if (g == 2) pooled_tile_to_lds<8>(Z + 512, lds, row0, t0, tid);
    else pooled_tile_to_lds<16>(Z + 768, lds, row0, t0, tid);
    bf16x8v Bf[16];
    { int zb; asm volatile("v_mov_b32 %0, 0" : "=v"(zb));
      const bf16* wfr = WPF + (size_t)g * 65536 + (size_t)(wv * 16) * 512 + (lane + zb) * 8;
#pragma unroll
      for (int ks = 0; ks < 16; ++ks) Bf[ks] = *(const bf16x8v*)(wfr + ks * 512); }
    const float bq = b_pool[g * 256 + c], sq = pool_scale[g * 256 + c];
    __syncthreads();
    unsigned short* yb = (unsigned short*)YP + (size_t)row0 * WP + g * 256;
    const int loff = 4 * h * WP + c;
#pragma unroll 1
    for (int mt = 0; mt < 4; ++mt) {
        f32x16 acc;
#pragma unroll
        for (int q = 0; q < 16; ++q) acc[q] = 0.f;
        LAS const unsigned char* abase = lds + (32 * mt + r) * 528 + h * 16;
#pragma unroll
        for (int ks = 0; ks < 16; ++ks) acc = __builtin_amdgcn_mfma_f32_32x32x16_bf16(*(LAS const bf16x8v*)(abase + ks * 32), Bf[ks], acc, 0, 0, 0);
#pragma unroll
        for (int q = 0; q < 16; q += 2) { const int tl = (q & 3) + 8 * (q >> 2);
            const unsigned w = pg8::cvt_pk_bf16((acc[q] + bq) * sq, (acc[q + 1] + bq) * sq);
            (yb + (size_t)(32 * mt + tl) * WP)[loff] = (unsigned short)(w & 0xffffu); (yb + (size_t)(32 * mt + tl + 1) * WP)[loff] = (unsigned short)(w >> 16); }
    }
}

__global__ void __launch_bounds__(NTHR, 2) fwd_kernel(Args args) {
    extern __shared__ __attribute__((aligned(16))) unsigned char lds_raw[];
    LAS unsigned char* lds = (LAS unsigned char*)lds_raw;
    cg::grid_group grid = cg::this_grid();
    const int tid0 = threadIdx.x, wave = __builtin_amdgcn_readfirstlane(tid0 >> 6);
#define PH_IDS int _z; asm volatile("v_mov_b32 %0, 0" : "=v"(_z)); const int tid = (int)threadIdx.x + _z, lane = tid & 63; (void)lane; (void)tid;
    const int G = gridDim.x, blk = blockIdx.x;
    const int gw = blk * NWAVES + wave, NGW = G * NWAVES;
    unsigned char* ws = args.ws;
    const float* x = args.in[0]; const float* cvec = args.in[1]; const float* norm_g = args.in[2]; const float* w_ada = args.in[3]; const float* b_ada = args.in[4];
    const float* w_in = args.in[5]; const float* b_in = args.in[6]; const float* w_pool = args.in[7]; const float* b_pool = args.in[8]; const float* pool_scale = args.in[9];
    const float* conv_w = args.in[10]; const float* conv_b = args.in[11]; const float* w_gate = args.in[12]; const float* b_gate = args.in[13]; const float* lru_lambda = args.in[14];
    const float* onp_g = args.in[15]; const float* onl_g = args.in[16]; const float* w_out = args.in[17]; const float* b_out = args.in[18]; const float* fin_g = args.in[19];
    float* out = args.out;
    float* MODP = (float*)(ws + WS_MODP); float* GATE = (float*)(ws + WS_GATE); float* AGG = (float*)(ws + WS_AGG);
    bf16* WIN_T = (bf16*)(ws + WS_WIN); bf16* WOUT_T = (bf16*)(ws + WS_WOUT); bf16* WGATE_T = (bf16*)(ws + WS_WGATE); bf16* WPOOL_T = (bf16*)(ws + WS_WPOOL);
    bf16* HB = (bf16*)(ws + WS_H); bf16* Z = (bf16*)(ws + WS_Z); bf16* UC = (bf16*)(ws + WS_UC); bf16* POOLED = (bf16*)(ws + WS_POOLED);
    bf16* GT = (bf16*)(ws + WS_GT); bf16* YP = (bf16*)(ws + WS_YP);
    bf16* HLF = (bf16*)(ws + WS_HLF); bf16* HLB = (bf16*)(ws + WS_HLB); bf16* PF = (bf16*)(ws + WS_PF); bf16* PB = (bf16*)(ws + WS_PB); bf16* A2 = (bf16*)(ws + WS_A2);

    const int lo = args.ph_lo, hi = args.ph_hi;
#define IN(k) (lo <= (k) && (k) < hi)
#define SEAM(k) do { if (IN(k) && IN((k) + 1)) xcd_barrier(bar); } while (0)
    volatile LAS unsigned* MISC = (volatile LAS unsigned*)(lds + LDS_BYTES - 256);
    if (tid0 < 32) MISC[tid0] = 0u;
    __syncthreads();
    XcdBarrier bar; bar.bar = (unsigned*)ws; bar.x = 0; bar.st = MISC;
    if (hi - lo > 1) bar = xcd_barrier_post((unsigned*)ws, MISC);
    if (lo > 1000) grid.sync();

    if (IN(0)) {
        PH_IDS
        if (blk < 24 * KC_MOD) {
            const int cc = blk % 24, kc = blk / 24, kb = kc * 256 + wave * 32, col = cc * 256 + lane * 4;
            float cs[NB];
#pragma unroll
            for (int b = 0; b < NB; ++b) cs[b] = siluf_(cvec[b * DM + kb + (lane & 31)]);
            f32x4 acc[NB];
#pragma unroll
            for (int b = 0; b < NB; ++b) acc[b] = (f32x4){0.f, 0.f, 0.f, 0.f};
            const float* wp = w_ada + (size_t)kb * (3 * DM) + col;
#pragma unroll 16
            for (int i = 0; i < 32; ++i) { const f32x4 wv = __builtin_nontemporal_load((const f32x4*)(wp + (size_t)i * (3 * DM)));
#pragma unroll
                for (int b = 0; b < NB; ++b) { const float s = __shfl(cs[b], i); acc[b] += wv * s; } }
            LAS float* red = (LAS float*)lds;
#pragma unroll
            for (int b = 0; b < NB; ++b) *(LAS f32x4*)(red + (wave * NB + b) * 256 + lane * 4) = acc[b];
            __syncthreads();
#pragma unroll
            for (int e = 0; e < 2; ++e) { const int o = tid * 2 + e, b = o >> 8, cl = o & 255; float s = 0.f;
#pragma unroll
                for (int w = 0; w < NWAVES; ++w) s += red[(w * NB + b) * 256 + cl];
                MODP[(size_t)(kc * NB + b) * (3 * DM) + cc * 256 + cl] = s; }
            __syncthreads();
        }
        LAS float* scr = (LAS float*)(lds + wave * 16384);
        constexpr int I_IN = (DM / 64) * (NZ / 32), I_G1 = (256 / 64) * (512 / 32), I_P1 = (256 / 64) * (256 / 32);
        constexpr int NITEMS = I_IN + 8 * I_G1 + 4 * I_P1;
        const int nmod = (G > 24 * KC_MOD) ? 24 * KC_MOD : G;
        const int nvb = nmod + (G - nmod) * 3;
        const int nv = (blk < nmod) ? 1 : 3, v0 = (blk < nmod) ? blk : nmod + (blk - nmod) * 3;
        for (int vi = 0; vi < nv; ++vi)
            for (int it = (v0 + vi) * NWAVES + wave; it < NITEMS; it += nvb * NWAVES) {
                int r = it;
                if (r < I_IN) { p0_transpose_item(w_in, DM, NZ, WIN_T, 0, scr, r, lane); continue; } r -= I_IN;
                if (r < 8 * I_G1) { const int mi = r / I_G1; p0_transpose_item(w_gate + (size_t)mi * 256 * 512, 256, 512, WGATE_T, mi * 512, scr, r % I_G1, lane, true, -1.44269504f); continue; } r -= 8 * I_G1;
                { const int mi = r / I_P1; p0_transpose_item(w_pool + (size_t)mi * 256 * 256, 256, 256, WPOOL_T, mi * 256, scr, r % I_P1, lane, false, 1.f, true); }
            }
    }
    SEAM(0);

    if (IN(1)) {
        PH_IDS
        if (blk == 0) for (int i = tid; i < 2 * WL; i += NTHR) ((float*)(ws + WS_SP8))[i] = (-8.f * 1.44269504f) * log1pf(__expf(-lru_lambda[i]));
        LAS float* cA = (LAS float*)lds; LAS float* cB = cA + DM;
        for (int rb = blk; rb < MROWS / 32; rb += G) {
            const int b = rb / (SEQ / 32);
            __syncthreads();
            { const int c0 = tid * 4; f32x4 sh = *(const f32x4*)(b_ada + c0), sc = *(const f32x4*)(b_ada + DM + c0);
#pragma unroll
              for (int kc = 0; kc < KC_MOD; ++kc) { sh += *(const f32x4*)(MODP + (size_t)(kc * NB + b) * (3 * DM) + c0); sc += *(const f32x4*)(MODP + (size_t)(kc * NB + b) * (3 * DM) + DM + c0); }
              const f32x4 ng = *(const f32x4*)(norm_g + c0);
              *(LAS f32x4*)(cA + c0) = ng * (sc + 1.f); *(LAS f32x4*)(cB + c0) = sh; }
            if (tid < 32) { const int idx = rb * 32 + tid, bb = idx / DM, cl = idx % DM; float s = b_ada[2 * DM + cl];
#pragma unroll
                for (int kc = 0; kc < KC_MOD; ++kc) s += MODP[(size_t)(kc * NB + bb) * (3 * DM) + 2 * DM + cl];
                GATE[idx] = s; }
            __syncthreads();
#pragma unroll 1
            for (int q = 0; q < 4; q += 2) {
                const int row = rb * 32 + wave * 4 + q;
                const f32x4* xr = (const f32x4*)(x + (size_t)row * DM) + lane;
                f32x4 v[2][8]; float s[2] = {0.f, 0.f};
#pragma unroll
                for (int r2 = 0; r2 < 2; ++r2)
#pragma unroll
                    for (int j = 0; j < 8; ++j) v[r2][j] = __builtin_nontemporal_load(xr + r2 * (DM / 4) + 64 * j);
#pragma unroll
                for (int r2 = 0; r2 < 2; ++r2) {
#pragma unroll
                    for (int j = 0; j < 8; ++j) s[r2] += (v[r2][j].x * v[r2][j].x + v[r2][j].y * v[r2][j].y) + (v[r2][j].z * v[r2][j].z + v[r2][j].w * v[r2][j].w);
                    const float rstd = rsqrtf(wave_sum(s[r2]) * (1.f / DM) + EPS);
                    u32x2* o8 = (u32x2*)(HB + (size_t)(row + r2) * DM) + lane;
#pragma unroll
                    for (int j = 0; j < 8; ++j) { const int c0 = (64 * j + lane) * 4; const f32x4 a = *(const LAS f32x4*)(cA + c0), bb = *(const LAS f32x4*)(cB + c0);
                        const f32x4 h = v[r2][j] * rstd * a + bb; u32x2 w; w.x = pk2(h.x, h.y); w.y = pk2(h.z, h.w); o8[64 * j] = w; }
                }
            }
        }
    }
    SEAM(1);

    if (IN(2)) {
        PH_IDS
        pg8::Gemm g{HB, WIN_T, MROWS, NZ, DM, DM, 0, 0}; pg8::StaticOrder S; S.init(MROWS, NZ, G, blk);
        pg8::EpiBf16 E{Z, NZ, b_in, nullptr};
        pg8::gemm_phase<pg8::EpiBf16, pg8::StaticOrder, true, true>(lds, g, S, E);
    }
    SEAM(2);


    if (IN(4)) {
        PH_IDS
        static_assert(CHUNK == 128, "the gate phase scans 128-token chunks");
        for (int it = blk; it < (MROWS / 128) * 4; it += G) gate_item(lds, Z + WP, conv_w, conv_b, WGATE_T, b_gate, (const float*)(ws + WS_SP8), HLF, HLB, PF, PB, AGG, it);
        __syncthreads();
        for (int it = blk; it < (MROWS / 128) * 4; it += G) pool_item(lds, Z, WPOOL_T, b_pool, pool_scale, YP, it);
        __syncthreads();
        {
            constexpr int I_OUT = (DM / 64) * (DM / 32);
            LAS float* scr = (LAS float*)(lds + wave * 16384);
            int z3; asm volatile("v_mov_b32 %0, 0" : "=v"(z3)); const int ln3 = ((int)threadIdx.x + z3) & 63;
            for (int it = blk * NWAVES + wave; it < I_OUT; it += G * NWAVES) p0_transpose_item(w_out, DM, DM, WOUT_T, 0, scr, it, ln3);
        }
    }
    SEAM(4);

    if (IN(5)) {
        PH_IDS
        LAS float* cHf = (LAS float*)lds; LAS float* cHb = cHf + WL;
        for (int rb = blk; rb < MROWS / 32; rb += G) {
            const int b = rb / (SEQ / 32), chunk = (rb % (SEQ / 32)) / (CHUNK / 32);
            __syncthreads();
#pragma unroll 1
            for (int dir = 0; dir < 2; ++dir) {
                float pv[2][NCHUNK], hv[2][NCHUNK];
                const float* agb = AGG + (size_t)(b * NCHUNK * 4 + dir * 2) * WL + tid;
#pragma unroll
                for (int qi = 0; qi < 2; ++qi)
#pragma unroll
                    for (int jj = 0; jj < NCHUNK; ++jj) { pv[qi][jj] = agb[(size_t)jj * 4 * WL + qi * NTHR]; hv[qi][jj] = agb[(size_t)jj * 4 * WL + WL + qi * NTHR]; }
#pragma unroll
                for (int qi = 0; qi < 2; ++qi) { float Hf = 0.f, Hb = 0.f;
#pragma unroll
                    for (int jj = 0; jj < NCHUNK; ++jj) Hf = (jj < chunk) ? (hv[qi][jj] + pv[qi][jj] * Hf) : Hf;
#pragma unroll
                    for (int jj = NCHUNK - 1; jj >= 0; --jj) Hb = (jj > chunk) ? (hv[qi][jj] + pv[qi][jj] * Hb) : Hb;
                    (dir ? cHb : cHf)[tid + qi * NTHR] = dir ? Hb : Hf; }
            }
            __syncthreads();
#pragma unroll 1
            for (int q = 0; q < 4; ++q) {
                const int row = rb * 32 + wave * 4 + q;
                { float y[2][8]; float ss = 0.f;
#pragma unroll
                  for (int j = 0; j < 2; ++j) { const int c0 = (j * 64 + lane) * 8; unpack8(*(const u32x4*)(YP + (size_t)row * WP + c0), y[j]);
#pragma unroll
                      for (int e = 0; e < 8; ++e) ss += y[j][e] * y[j][e]; }
                  const float rstd = rsqrtf(wave_sum(ss) * (1.f / WP) + EPS);
#pragma unroll
                  for (int j = 0; j < 2; ++j) { const int c0 = (j * 64 + lane) * 8; float gp[8], o[8]; unpack8(*(const u32x4*)(Z + (size_t)row * NZ + 2048 + c0), gp);
                      const f32x4 g0 = *(const f32x4*)(onp_g + c0), g1 = *(const f32x4*)(onp_g + c0 + 4); const float gg[8] = {g0.x, g0.y, g0.z, g0.w, g1.x, g1.y, g1.z, g1.w};
#pragma unroll
                      for (int e = 0; e < 8; ++e) o[e] = y[j][e] * rstd * gg[e] * siluf_(gp[e]);
                      *(u32x4*)(A2 + (size_t)row * DM + c0) = pack8(o); } }
                { float y[2][8]; float ss = 0.f;
#pragma unroll
                  for (int j = 0; j < 2; ++j) { const int c0 = (j * 64 + lane) * 8; float hf[8], hb[8], pf[8], pb[8];
                      unpack8(*(const u32x4*)(HLF + (size_t)row * WL + c0), hf);
#pragma unroll
                      for (int e = 0; e < 8; ++e) hb[e] = 0.f;
                      unpack8(*(const u32x4*)(PF + (size_t)row * WL + c0), pf); unpack8(*(const u32x4*)(PB + (size_t)row * WL + c0), pb);
#pragma unroll
                      for (int e = 0; e < 8; ++e) { const float v = hf[e] + hb[e] + pf[e] * cHf[c0 + e] + pb[e] * cHb[c0 + e]; y[j][e] = v; ss += v * v; } }
                  const float rstd = rsqrtf(wave_sum(ss) * (1.f / WL) + EPS);
#pragma unroll
                  for (int j = 0; j < 2; ++j) { const int c0 = (j * 64 + lane) * 8; float gp[8], o[8]; unpack8(*(const u32x4*)(Z + (size_t)row * NZ + 3072 + c0), gp);
                      const f32x4 g0 = *(const f32x4*)(onl_g + c0), g1 = *(const f32x4*)(onl_g + c0 + 4); const float gg[8] = {g0.x, g0.y, g0.z, g0.w, g1.x, g1.y, g1.z, g1.w};
#pragma unroll
                      for (int e = 0; e < 8; ++e) o[e] = y[j][e] * rstd * gg[e] * siluf_(gp[e]);
                      *(u32x4*)(A2 + (size_t)row * DM + WP + c0) = pack8(o); } }
            }
        }
    }
    SEAM(5);

    const bool fuse_norm = (G == (MROWS / 256) * (DM / 256));
    if (IN(6)) {
        PH_IDS
        pg8::Gemm g{A2, WOUT_T, MROWS, DM, DM, DM, 0, 0}; pg8::StaticOrder S; S.init(MROWS, DM, G, blk);
        if (fuse_norm) {
            pg8::EpiResidNorm E{out, x, GATE, b_out, fin_g, DM, SEQ, (float*)(ws + WS_SLOT), (unsigned*)ws + 4096, DM / 256, EPS, MROWS};
            pg8::gemm_phase<pg8::EpiResidNorm, pg8::StaticOrder, false, true>(lds, g, S, E);
        } else {
            pg8::EpiResid E{out, x, GATE, b_out, DM, SEQ};
            pg8::gemm_phase<pg8::EpiResid, pg8::StaticOrder, false, true>(lds, g, S, E);
        }
    }
    if (!fuse_norm) SEAM(6);

    if (IN(7) && !fuse_norm) {
        PH_IDS
        for (int row = gw; row < MROWS; row += NGW) {
            f32x4* xr = (f32x4*)(out + (size_t)row * DM) + lane;
            f32x4 v[8]; float s = 0.f;
#pragma unroll
            for (int j = 0; j < 8; ++j) { v[j] = xr[64 * j]; s += (v[j].x * v[j].x + v[j].y * v[j].y) + (v[j].z * v[j].z + v[j].w * v[j].w); }
            const float rstd = rsqrtf(wave_sum(s) * (1.f / DM) + EPS);
#pragma unroll
            for (int j = 0; j < 8; ++j) { const f32x4 gg = *((const f32x4*)fin_g + 64 * j + lane); xr[64 * j] = v[j] * rstd * gg; }
        }
    }
#undef IN
#undef SEAM
}

extern "C" void kernel_launch(void* const* d_in, const int* in_sizes, int n_in, void* d_out, int out_size, void* d_ws, size_t ws_size, hipStream_t stream) {
    static int grid = 0;
    if (grid == 0) {
        if (n_in != 20 || out_size != MROWS * DM || ws_size < WS_END) { fprintf(stderr, "kernel_launch: unexpected shapes (n_in %d out %d ws %zu)\n", n_in, out_size, ws_size); grid = -1; return; }
        int dev = 0, cus = 0, per_cu = 0;
        if (hipGetDevice(&dev) != hipSuccess || hipDeviceGetAttribute(&cus, hipDeviceAttributeMultiprocessorCount, dev) != hipSuccess) { grid = -1; return; }
        if (hipFuncSetAttribute((const void*)fwd_kernel, hipFuncAttributeMaxDynamicSharedMemorySize, LDS_BYTES) != hipSuccess) { fprintf(stderr, "kernel_launch: hipFuncSetAttribute failed\n"); grid = -1; return; }
        if (hipOccupancyMaxActiveBlocksPerMultiprocessor(&per_cu, (const void*)fwd_kernel, NTHR, LDS_BYTES) != hipSuccess || per_cu < 1) { fprintf(stderr, "kernel_launch: occupancy query says %d\n", per_cu); per_cu = 1; }
        (void)hipGetLastError();
        grid = cus * 1;
        fprintf(stderr, "kernel_launch: grid %d (cus %d, per_cu %d)\n", grid, cus, per_cu);
    }
    if (grid < 0) return;
    if (hipMemsetAsync(d_ws, 0, 65536, stream) != hipSuccess) { fprintf(stderr, "kernel_launch: memset failed\n"); return; }
    Args a{};
    for (int i = 0; i < 20; ++i) a.in[i] = (const float*)d_in[i];
    a.out = (float*)d_out; a.ws = (unsigned char*)d_ws;
    constexpr int NPH = 8;
#if MK_N_LAUNCHES == 1
    a.ph_lo = 0; a.ph_hi = NPH;
    void* kargs[] = {&a};
    hipError_t e = hipLaunchCooperativeKernel((const void*)fwd_kernel, dim3(grid), dim3(NTHR), kargs, LDS_BYTES, stream);
    if (e != hipSuccess) fprintf(stderr, "cooperative launch failed: %s (grid %d)\n", hipGetErrorString(e), grid);
#else
    for (int p = 0; p < NPH; ++p) {
        const int reps = ((PROBE_MASK >> p) & 1) ? 2 : 1;
        for (int r = 0; r < reps; ++r) {
            a.ph_lo = p; a.ph_hi = p + 1;
            void* kargs[] = {&a};
            hipError_t e = hipLaunchCooperativeKernel((const void*)fwd_kernel, dim3(grid), dim3(NTHR), kargs, LDS_BYTES, stream);
            if (e != hipSuccess) { fprintf(stderr, "launch %d failed: %s\n", p, hipGetErrorString(e)); break; }
        }
    }
#endif
}
```
